# Optimizing an MI355X kernel written in HIP

```python
import jax, jax.numpy as jnp
from jax import lax
import numpy as np

D_MODEL = 1024
BATCH = 4
SEQ = 4096
DEPTH = 2

HEAD_DIM = 64
N_FOX_HEADS = 8
N_MOBA_HEADS = 8
FOX_WIDTH = N_FOX_HEADS * HEAD_DIM
MOBA_WIDTH = N_MOBA_HEADS * HEAD_DIM
ATTN_WIDTH = FOX_WIDTH + MOBA_WIDTH
IN_COLS = 3 * ATTN_WIDTH + N_FOX_HEADS
Q_BLOCK = 128
MOBA_BLOCK = 256
MOBA_TOPK = 3
MOBA_Q_CHUNK = 32
N_RWKV_HEADS = D_MODEL // HEAD_DIM
D_DECAY_LORA = 64
D_AAA_LORA = 64
D_GATE_LORA = 160
D_FF = -(-8 * D_MODEL // (3 * 256)) * 256
NORM_EPS = 1e-6
GN_EPS = HEAD_DIM * 1e-5
N_EVEN = (DEPTH + 1) // 2
N_ODD = DEPTH // 2

kernel_name = "fox_moba_rwkv7_adaln_hybrid"

F32 = jnp.float32


def rmsnorm(x, g):
    xf = x.astype(F32)
    y = xf * lax.rsqrt(jnp.mean(xf * xf, axis=-1, keepdims=True) + NORM_EPS)
    return y.astype(x.dtype) * g


def modulate(h, shift, scale):
    return h * (1.0 + scale[:, None, :]) + shift[:, None, :]


def split_heads(t, n_heads):
    b, s, _ = t.shape
    return t.reshape(b, s, n_heads, HEAD_DIM).transpose(0, 2, 1, 3)


def fox_attention(q, k, v, f_logit):
    b, h, s, dh = q.shape
    cum = jnp.cumsum(jax.nn.log_sigmoid(f_logit.astype(F32)), axis=-1)
    q = q * (dh ** -0.5)
    outs = []
    for i in range(s // Q_BLOCK):
        lo, hi = i * Q_BLOCK, (i + 1) * Q_BLOCK
        logits = jnp.einsum('bhqd,bhkd->bhqk', q[:, :, lo:hi], k[:, :, :hi]).astype(F32)
        logits = logits + cum[:, :, lo:hi, None] - cum[:, :, None, :hi]
        causal = jnp.arange(lo, hi)[:, None] >= jnp.arange(hi)[None, :]
        p = jax.nn.softmax(jnp.where(causal, logits, -jnp.inf), axis=-1)
        outs.append(jnp.einsum('bhqk,bhkd->bhqd', p.astype(v.dtype), v[:, :, :hi]))
    return jnp.concatenate(outs, axis=2)


def moba_attention(q, k, v):
    b, h, s, dh = q.shape
    nb = -(-s // MOBA_BLOCK)
    pad = nb * MOBA_BLOCK - s
    padw = ((0, 0), (0, 0), (0, pad), (0, 0))
    k_blocks = jnp.pad(k, padw).reshape(b, h, nb, MOBA_BLOCK, dh)
    v_blocks = jnp.pad(v, padw).reshape(b, h, nb, MOBA_BLOCK, dh)
    q = q * (dh ** -0.5)
    k_mean = jnp.mean(k_blocks.astype(F32), axis=3)
    q_blk = jnp.arange(s) // MOBA_BLOCK
    gate = jnp.einsum('bhsd,bhnd->bhsn', q.astype(F32), k_mean)
    fully_past = jnp.arange(nb)[None, :] < q_blk[:, None]
    gate = jnp.where(fully_past, gate, -jnp.inf)
    n_sel = min(MOBA_TOPK, nb)
    _, sel_idx = lax.top_k(gate, n_sel)
    sel_valid = jnp.arange(n_sel)[None, :] < q_blk[:, None]

    nc = s // MOBA_Q_CHUNK
    q_c = jnp.moveaxis(q.reshape(b, h, nc, MOBA_Q_CHUNK, dh), 2, 0)
    idx_c = jnp.moveaxis(sel_idx.reshape(b, h, nc, MOBA_Q_CHUNK, n_sel), 2, 0)
    valid_c = sel_valid.reshape(nc, MOBA_Q_CHUNK, n_sel)
    gather = jax.vmap(jax.vmap(lambda blocks, idx: blocks[idx]))

    def chunk(args):
        qq, ii, vv, ci = args
        qpos = ci * MOBA_Q_CHUNK + jnp.arange(MOBA_Q_CHUNK)
        own = (ci * MOBA_Q_CHUNK) // MOBA_BLOCK
        kg = gather(k_blocks, ii)
        vg = gather(v_blocks, ii)
        s_sel = jnp.einsum('bhqd,bhqnkd->bhqnk', qq, kg).astype(F32)
        s_sel = jnp.where(vv[None, None, :, :, None], s_sel, -jnp.inf)
        k_own = lax.dynamic_index_in_dim(k_blocks, own, axis=2, keepdims=False)
        v_own = lax.dynamic_index_in_dim(v_blocks, own, axis=2, keepdims=False)
        s_own = jnp.einsum('bhqd,bhkd->bhqk', qq, k_own).astype(F32)
        own_pos = own * MOBA_BLOCK + jnp.arange(MOBA_BLOCK)
        s_own = jnp.where(own_pos[None, :] <= qpos[:, None], s_own, -jnp.inf)
        logits = jnp.concatenate([s_sel.reshape(b, h, MOBA_Q_CHUNK, n_sel * MOBA_BLOCK), s_own], axis=-1)
        p = jax.nn.softmax(logits, axis=-1).astype(v.dtype)
        p_sel = p[..., :n_sel * MOBA_BLOCK].reshape(b, h, MOBA_Q_CHUNK, n_sel, MOBA_BLOCK)
        p_own = p[..., n_sel * MOBA_BLOCK:]
        return (jnp.einsum('bhqnk,bhqnkd->bhqd', p_sel, vg)
                + jnp.einsum('bhqk,bhkd->bhqd', p_own, v_own))

    out = lax.map(chunk, (q_c, idx_c, valid_c, jnp.arange(nc)))
    return jnp.moveaxis(out, 0, 2).reshape(b, h, s, dh)


def parallel_attention(h, w_in, b_f, w_out):
    b, s, _ = h.shape
    proj = h @ w_in
    qa, ka, va, qb, kb, vb = [proj[..., i * FOX_WIDTH:(i + 1) * FOX_WIDTH] for i in range(6)]
    f_logit = (proj[..., 3 * ATTN_WIDTH:] + b_f).transpose(0, 2, 1)
    o_a = fox_attention(split_heads(qa, N_FOX_HEADS), split_heads(ka, N_FOX_HEADS),
                        split_heads(va, N_FOX_HEADS), f_logit)
    o_b = moba_attention(split_heads(qb, N_MOBA_HEADS), split_heads(kb, N_MOBA_HEADS),
                         split_heads(vb, N_MOBA_HEADS))
    o = jnp.concatenate([o_a, o_b], axis=1)
    return o.transpose(0, 2, 1, 3).reshape(b, s, ATTN_WIDTH) @ w_out


def rwkv7_step(state, inp):
    r_t, w_t, k_t, v_t, a_t, b_t = inp
    sa = jnp.einsum('bhij,bhj->bhi', state, a_t)
    state = (state * w_t[:, :, None, :] + sa[..., None] * b_t[:, :, None, :]
             + v_t[..., None] * k_t[:, :, None, :])
    return state, jnp.einsum('bhij,bhj->bhi', state, r_t)


def rwkv7_time_mix(h, mu, w_r, w_k, w_v, w_o, w0, w1, w2, a0, a1, a2, g1, g2,
                   k_k, k_a, r_k, ln_w, ln_b):
    b, s, d = h.shape
    nh, n = N_RWKV_HEADS, HEAD_DIM
    xx = jnp.pad(h, ((0, 0), (1, 0), (0, 0)))[:, :-1] - h
    xr, xw, xk, xv, xa, xg = [h + xx * mu[i] for i in range(6)]
    r = xr @ w_r
    k = xk @ w_k
    v = xv @ w_v
    w_log = -jax.nn.softplus(-(w0 + jnp.tanh(xw @ w1) @ w2).astype(F32)) - 0.5
    decay = jnp.exp(-jnp.exp(w_log))
    a = jax.nn.sigmoid(a0 + (xa @ a1) @ a2)
    g = jax.nn.sigmoid(xg @ g1) @ g2
    kk = (k * k_k).reshape(b, s, nh, n).astype(F32)
    kk = kk / jnp.maximum(jnp.sqrt(jnp.sum(kk * kk, axis=-1, keepdims=True)), 1e-12)
    k = k * (1.0 + (a - 1.0) * k_a)
    heads = lambda t: t.reshape(b, s, nh, n).astype(F32)
    r_h, k_h, v_h, a_h, dec_h = heads(r), heads(k), heads(v), heads(a), heads(decay)
    xs = tuple(jnp.moveaxis(t, 1, 0) for t in (r_h, dec_h, k_h, v_h, -kk, kk * a_h))
    state0 = jnp.zeros((b, nh, n, n), F32)
    _, y = lax.scan(rwkv7_step, state0, xs)
    y = jnp.moveaxis(y, 0, 1)
    mean = jnp.mean(y, axis=-1, keepdims=True)
    var = jnp.mean(jnp.square(y - mean), axis=-1, keepdims=True)
    y = (y - mean) * lax.rsqrt(var + GN_EPS) * ln_w.reshape(nh, n).astype(F32) + ln_b.reshape(nh, n).astype(F32)
    bonus = jnp.sum(r_h * k_h * r_k.astype(F32), axis=-1, keepdims=True) * v_h
    out = (y + bonus).reshape(b, s, d).astype(h.dtype) * g
    return out @ w_o


def swiglu(h, w_in, w_out):
    gate, up = jnp.split(h @ w_in, 2, axis=-1)
    return (jax.nn.silu(gate) * up) @ w_out


def setup_inputs(seed: int = 0) -> dict:
    key = jax.random.key(seed)
    ks = iter(jax.random.split(key, 40))
    D = D_MODEL
    nrm = lambda shape, scale: jax.random.normal(next(ks), shape, F32) * scale
    uni = lambda shape, lo, hi: jax.random.uniform(next(ks), shape, F32, lo, hi)
    return {
        "x": nrm((BATCH, SEQ, D), 1.0),
        "c": nrm((BATCH, D), 1.0),
        "attn_w_in": nrm((N_EVEN, D, IN_COLS), D ** -0.5),
        "attn_b_f": uni((N_EVEN, N_FOX_HEADS), 1.0, 6.0),
        "attn_w_out": nrm((N_EVEN, ATTN_WIDTH, D), ATTN_WIDTH ** -0.5),
        "rwkv_mu": uni((N_ODD, 6, D), 0.0, 1.0),
        "rwkv_w_r": nrm((N_ODD, D, D), D ** -0.5),
        "rwkv_w_k": nrm((N_ODD, D, D), D ** -0.5),
        "rwkv_w_v": nrm((N_ODD, D, D), D ** -0.5),
        "rwkv_w_o": nrm((N_ODD, D, D), D ** -0.5),
        "rwkv_w0": uni((N_ODD, D), -6.0, -1.0),
        "rwkv_w1": nrm((N_ODD, D, D_DECAY_LORA), D ** -0.5),
        "rwkv_w2": nrm((N_ODD, D_DECAY_LORA, D), 0.5 * D_DECAY_LORA ** -0.5),
        "rwkv_a0": nrm((N_ODD, D), 0.1),
        "rwkv_a1": nrm((N_ODD, D, D_AAA_LORA), D ** -0.5),
        "rwkv_a2": nrm((N_ODD, D_AAA_LORA, D), 0.5 * D_AAA_LORA ** -0.5),
        "rwkv_g1": nrm((N_ODD, D, D_GATE_LORA), D ** -0.5),
        "rwkv_g2": nrm((N_ODD, D_GATE_LORA, D), D_GATE_LORA ** -0.5),
        "rwkv_k_k": 0.85 + nrm((N_ODD, D), 0.05),
        "rwkv_k_a": 1.0 + nrm((N_ODD, D), 0.05),
        "rwkv_r_k": nrm((N_ODD, N_RWKV_HEADS, HEAD_DIM), 0.1),
        "rwkv_ln_w": 1.0 + nrm((N_ODD, D), 0.05),
        "rwkv_ln_b": nrm((N_ODD, D), 0.02),
        "mod_w": nrm((DEPTH, D, 6 * D), 0.5 * D ** -0.5),
        "mod_b": nrm((DEPTH, 6 * D), 0.02),
        "norm_mix": 1.0 + nrm((DEPTH, D), 0.05),
        "norm_ffn": 1.0 + nrm((DEPTH, D), 0.05),
        "ffn_w_in": nrm((DEPTH, D, 2 * D_FF), D ** -0.5),
        "ffn_w_out": nrm((DEPTH, D_FF, D), D_FF ** -0.5),
        "norm_final": 1.0 + nrm((D,), 0.05),
    }


def reference(x, c, attn_w_in, attn_b_f, attn_w_out, rwkv_mu, rwkv_w_r, rwkv_w_k, rwkv_w_v,
              rwkv_w_o, rwkv_w0, rwkv_w1, rwkv_w2, rwkv_a0, rwkv_a1, rwkv_a2, rwkv_g1, rwkv_g2,
              rwkv_k_k, rwkv_k_a, rwkv_r_k, rwkv_ln_w, rwkv_ln_b, mod_w, mod_b, norm_mix,
              norm_ffn, ffn_w_in, ffn_w_out, norm_final):
    cond = jax.nn.silu(c)
    for i in range(DEPTH):
        mod = cond @ mod_w[i] + mod_b[i]
        sh_m, sc_m, gt_m, sh_f, sc_f, gt_f = jnp.split(mod, 6, axis=-1)
        h = modulate(rmsnorm(x, norm_mix[i]), sh_m, sc_m)
        j = i // 2
        if i % 2 == 0:
            y = parallel_attention(h, attn_w_in[j], attn_b_f[j], attn_w_out[j])
        else:
            y = rwkv7_time_mix(h, rwkv_mu[j], rwkv_w_r[j], rwkv_w_k[j], rwkv_w_v[j], rwkv_w_o[j],
                               rwkv_w0[j], rwkv_w1[j], rwkv_w2[j], rwkv_a0[j], rwkv_a1[j],
                               rwkv_a2[j], rwkv_g1[j], rwkv_g2[j], rwkv_k_k[j], rwkv_k_a[j],
                               rwkv_r_k[j], rwkv_ln_w[j], rwkv_ln_b[j])
        x = x + gt_m[:, None, :] * y
        h = modulate(rmsnorm(x, norm_ffn[i]), sh_f, sc_f)
        x = x + gt_f[:, None, :] * swiglu(h, ffn_w_in[i], ffn_w_out[i])
    return rmsnorm(x, norm_final)
```

```cpp
#include <hip/hip_runtime.h>
#include <cstdio>
#include <cstdint>

#ifndef MK_ONE_LAUNCH
#define MK_ONE_LAUNCH 1
#endif

namespace pg8 {
#define PG8_LAS __attribute__((address_space(3)))
typedef unsigned short bf16_t;
typedef short bf16x8 __attribute__((ext_vector_type(8)));
typedef float f32x4 __attribute__((ext_vector_type(4)));
typedef unsigned u32x4 __attribute__((ext_vector_type(4)));
constexpr int BM = 256, BK = 64, HALF = 128, HTB = HALF * BK * 2  , STAGE_BYTES = 8 * HTB, NXCD = 8, WGM = 8;

__host__ __device__ __forceinline__ int lds_byte(int r, int c) { const int st = (r >> 4) * 2 + (c >> 5), rr = r & 15, cc = c & 31, ob = rr * 64 + cc * 2; return st * 1024 + (ob ^ (((ob >> 9) & 1) << 5)); }
__host__ __device__ __forceinline__ void stage_rc(int b, int& R, int& C) { const int st = b / 1024, sb = b % 1024, swz = sb ^ (((sb >> 9) & 1) << 5); R = (st >> 1) * 16 + swz / 64; C = (st & 1) * 32 + (swz % 64) / 2; }
__host__ __device__ __forceinline__ int perm32(int rho) { const int n = rho >> 4, i = rho & 15; return 8 * (i >> 2) + 4 * n + (i & 3); }

struct Unit { int pm, pn; };
struct Gemm { const bf16_t* A; const bf16_t* Bt; int M, N, K; int lda; int gap;
    __device__ __forceinline__ const char* a_tile(int pm) const { return (const char*)(A + ((size_t)pm * BM + (size_t)(pm >> 4) * gap) * lda); } };

struct StaticOrder {
    int nM, nN, nwg, G, c;
    __host__ __device__ void init(int M, int N, int G_, int c_) { nM = M / BM; nN = N / BM; nwg = nM * nN; G = G_; c = c_; }
    __host__ __device__ bool next(int i, Unit& u) const {
        const long L = (long)i * G + c; if (L >= nwg) return false;
        int wgid = (int)L; { const int q = nwg / NXCD, r = nwg % NXCD, xcd = wgid % NXCD, off = wgid / NXCD; wgid = (xcd < r ? xcd * (q + 1) : r * (q + 1) + (xcd - r) * q) + off; }
        const int nig = WGM * nN, gid = wgid / nig, fm = gid * WGM, gsz = (nM - fm) < WGM ? (nM - fm) : WGM;
        u.pm = fm + ((wgid % nig) % gsz); u.pn = (wgid % nig) / gsz; return true;
    }
    __device__ __forceinline__ void a_ready(const Unit&) const {}
    __device__ __forceinline__ void done(const Unit&) const {}
};

__device__ __forceinline__ unsigned cvt_pk_bf16(float lo, float hi) { unsigned r; asm volatile("v_cvt_pk_bf16_f32 %0, %1, %2" : "=v"(r) : "v"(lo), "v"(hi)); return r; }
__device__ __forceinline__ float sigmoidf_(float x) { return __builtin_amdgcn_rcpf(1.f + __expf(-x)); }
__device__ __forceinline__ float tanhf_(float x) { return 1.f - 2.f * __builtin_amdgcn_rcpf(__expf(2.f * x) + 1.f); }

template <int ACT> struct EpiBf16 {
    static constexpr bool PERM = true, AFTER_DRAIN = false;
    bf16_t* O; int ldc; const float* p; int split_cols; size_t split_stride; float scale0;
    __device__ __forceinline__ float act(float v, float pv, int col) const {
        if (ACT == 1) return col < 128 ? tanhf_(v) : (col < 256 ? v : sigmoidf_(v));
        if (ACT == 2) return -0.6065306597126334f * sigmoidf_(pv + v);
        if (ACT == 3) return sigmoidf_(pv + v);
        return v;
    }
    __device__ __forceinline__ void operator()(const f32x4 (&acc)[2][2][4][2], const Unit& u, int wr, int wc, int fr, int fq) const {
        const int row0 = u.pm * BM + wr * 64 + fr; int colt = u.pn * BM; bf16_t* base = O;
        float sc = 1.f; if (split_cols) { const int t = colt / split_cols; base += (size_t)t * split_stride; colt -= t * split_cols; if (t == 0) sc = scale0; }
        const int col0 = colt + wc * 32 + 8 * fq, bcol0 = u.pn * BM + wc * 32 + 8 * fq;
#pragma unroll
        for (int bj = 0; bj < 2; ++bj) {
            const int cb = bcol0 + bj * HALF;
            f32x4 p0 = {0.f, 0.f, 0.f, 0.f}, p1 = {0.f, 0.f, 0.f, 0.f};
            if (ACT >= 2) { p0 = *(const f32x4*)(p + cb); p1 = *(const f32x4*)(p + cb + 4); }
#pragma unroll
            for (int ai = 0; ai < 2; ++ai)
#pragma unroll
                for (int m = 0; m < 4; ++m) { bf16_t* rowp = base + (size_t)(row0 + ai * HALF + m * 16) * ldc + col0 + bj * HALF;
                    f32x4 v0 = acc[ai][bj][m][0], v1 = acc[ai][bj][m][1];
                    if (ACT != 0) {
#pragma unroll
                        for (int e = 0; e < 4; ++e) { v0[e] = act(v0[e], p0[e], cb + e); v1[e] = act(v1[e], p1[e], cb + 4 + e); } }
                    v0 = v0 * sc; v1 = v1 * sc; u32x4 w; w.x = cvt_pk_bf16(v0[0], v0[1]); w.y = cvt_pk_bf16(v0[2], v0[3]); w.z = cvt_pk_bf16(v1[0], v1[1]); w.w = cvt_pk_bf16(v1[2], v1[3]);
                    *(u32x4*)rowp = w;
                    if (ACT >= 2 && (m & 1)) asm volatile("" ::: "memory"); }
        }
    }
};
struct EpiSwiglu {
    static constexpr bool PERM = true, AFTER_DRAIN = false;
    bf16_t* O; int ldc;
    __device__ __forceinline__ void operator()(const f32x4 (&acc)[2][2][4][2], const Unit& u, int wr, int wc, int fr, int fq) const {
        const int row0 = u.pm * BM + wr * 64 + fr, col0 = u.pn * HALF + wc * 32 + 8 * fq;
#pragma unroll
        for (int ai = 0; ai < 2; ++ai)
#pragma unroll
            for (int m = 0; m < 4; ++m) { bf16_t* rowp = O + (size_t)(row0 + ai * HALF + m * 16) * ldc + col0; float h[8];
#pragma unroll
                for (int n = 0; n < 2; ++n)
#pragma unroll
                    for (int e = 0; e < 4; ++e) { const float g = acc[ai][0][m][n][e], up = acc[ai][1][m][n][e]; h[4 * n + e] = g * sigmoidf_(g) * up; }
                u32x4 w; w.x = cvt_pk_bf16(h[0], h[1]); w.y = cvt_pk_bf16(h[2], h[3]); w.z = cvt_pk_bf16(h[4], h[5]); w.w = cvt_pk_bf16(h[6], h[7]);
                *(u32x4*)rowp = w; }
    }
};
struct EpiResid {
    static constexpr bool PERM = false, AFTER_DRAIN = false;
    const float* base; float* out; const float* gate; int gstride;
    __device__ __forceinline__ void operator()(const f32x4 (&acc)[2][2][4][2], const Unit& u, int wr, int wc, int fr, int fq) const {
        const int row0 = u.pm * BM + wr * 64 + fr, col0 = u.pn * BM + wc * 32 + 4 * fq; const float* gp = gate + (size_t)(u.pm >> 4) * gstride + col0;
        f32x4 gv[2][2];
#pragma unroll
        for (int bj = 0; bj < 2; ++bj)
#pragma unroll
            for (int n = 0; n < 2; ++n) gv[bj][n] = *(const f32x4*)(gp + bj * HALF + n * 16);
#pragma unroll
        for (int ai = 0; ai < 2; ++ai)
#pragma unroll
            for (int m = 0; m < 4; ++m) { const size_t off = (size_t)(row0 + ai * HALF + m * 16) * 1024 + col0;
#pragma unroll
                for (int bj = 0; bj < 2; ++bj)
#pragma unroll
                    for (int n = 0; n < 2; ++n) { const f32x4 bs = *(const f32x4*)(base + off + bj * HALF + n * 16); *(f32x4*)(out + off + bj * HALF + n * 16) = bs + gv[bj][n] * acc[ai][bj][m][n]; } }
    }
};

template <class Epi, class Sched, bool ALIGN_EPI = false, bool SP2 = false>
__device__ __forceinline__ void gemm_phase(PG8_LAS unsigned char* lds, const Gemm g, const Sched& S, const Epi& E) {
    const int tid = threadIdx.x, wid = __builtin_amdgcn_readfirstlane(tid >> 6), lane = tid & 63, wr = wid >> 2, wc = wid & 3, fr = lane & 15, fq = lane >> 4;
    const int K = g.K, nt = K / BK;
    unsigned voffA[2], voffB[2];
#pragma unroll
    for (int i = 0; i < 2; ++i) { int R, C; stage_rc(tid * 16 + i * 8192, R, C); const int Rb = Epi::PERM ? ((R & ~31) + perm32(R & 31)) : R;
        voffA[i] = (unsigned)(R * g.lda + C) * 2u; voffB[i] = (unsigned)(Rb * K + C) * 2u; }
    const size_t kstep = (size_t)(BK * 2);
    const size_t hstepA = (size_t)HALF * g.lda * 2, hstepB = (size_t)HALF * K * 2;
    const size_t tstepB = 2 * hstepB;
    const unsigned ldsw = (unsigned)wid * 1024u;
    const int aoff = lds_byte(wr * 64 + fr, fq * 8), boff = lds_byte(wc * 32 + fr, fq * 8);
#define PG8_SA(b, h) (((b) * 2 + (h)) * HTB)
#define PG8_SB(b, h) ((4 + (b) * 2 + (h)) * HTB)
#define PG8_STAGE(bufoff, gbase, voff) do { _Pragma("unroll") for (int _i = 0; _i < 2; ++_i) \
        __builtin_amdgcn_global_load_lds((const unsigned*)((const char*)(gbase) + (voff)[_i]), (PG8_LAS unsigned*)(lds + (bufoff) + ldsw + _i * 8192), 16, 0, 0); } while (0)
#define PG8_LDA(dst, b, h) do { _Pragma("unroll") for (int m = 0; m < 4; ++m) _Pragma("unroll") for (int k = 0; k < 2; ++k) dst[m][k] = *(const PG8_LAS bf16x8*)(lds + PG8_SA(b, h) + aoff + m * 2048 + k * 1024); } while (0)
#define PG8_LDB(dst, b, h) do { _Pragma("unroll") for (int n = 0; n < 2; ++n) _Pragma("unroll") for (int k = 0; k < 2; ++k) dst[n][k] = *(const PG8_LAS bf16x8*)(lds + PG8_SB(b, h) + boff + n * 2048 + k * 1024); } while (0)
#define PG8_MMA(ai, bj, At, Bt) do { __builtin_amdgcn_s_setprio(1); _Pragma("unroll") for (int m = 0; m < 4; ++m) _Pragma("unroll") for (int n = 0; n < 2; ++n) _Pragma("unroll") for (int k = 0; k < 2; ++k) \
        acc[ai][bj][m][n] = __builtin_amdgcn_mfma_f32_16x16x32_bf16(Bt[n][k], At[m][k], acc[ai][bj][m][n], 0, 0, 0); __builtin_amdgcn_s_setprio(0); } while (0)
#define PG8_WAIT_V(n) asm volatile("s_waitcnt vmcnt(" #n ")" ::: "memory")
#define PG8_WAIT_L(n) asm volatile("s_waitcnt lgkmcnt(" #n ")" ::: "memory")
#define PG8_BAR __builtin_amdgcn_s_barrier()
#define PG8_SCHED __builtin_amdgcn_sched_barrier(0)
    Unit cur, nxt; int ui = 0;
    if (!S.next(0, cur)) return;
    f32x4 acc[2][2][4][2];
#pragma unroll
    for (int a = 0; a < 2; ++a)
#pragma unroll
        for (int b = 0; b < 2; ++b)
#pragma unroll
            for (int m = 0; m < 4; ++m)
#pragma unroll
                for (int n = 0; n < 2; ++n) acc[a][b][m][n] = (f32x4){0.f, 0.f, 0.f, 0.f};
    bf16x8 At[4][2], B0[2][2], B1[2][2];
    const char* cA = g.a_tile(cur.pm); const char* cB = (const char*)g.Bt + (size_t)cur.pn * tstepB;
    S.a_ready(cur);
    if constexpr (SP2) {
        PG8_STAGE(PG8_SB(0, 0), cB, voffB); PG8_STAGE(PG8_SB(0, 1), cB + hstepB, voffB); PG8_STAGE(PG8_SA(0, 0), cA, voffA); PG8_STAGE(PG8_SA(0, 1), cA + hstepA, voffA);
        if (wr == 1) PG8_BAR;
        PG8_WAIT_V(2); PG8_BAR;
        PG8_STAGE(PG8_SB(1, 0), cB + kstep, voffB); PG8_STAGE(PG8_SA(1, 0), cA + kstep, voffA); PG8_STAGE(PG8_SB(1, 1), cB + hstepB + kstep, voffB);
        PG8_WAIT_V(6); PG8_BAR;
    } else {
        PG8_STAGE(PG8_SB(0, 0), cB, voffB); PG8_STAGE(PG8_SA(0, 0), cA, voffA); PG8_STAGE(PG8_SB(0, 1), cB + hstepB, voffB); PG8_STAGE(PG8_SA(0, 1), cA + hstepA, voffA);
        if (wr == 1) PG8_BAR;
        PG8_WAIT_V(4); PG8_BAR;
        PG8_STAGE(PG8_SB(1, 0), cB + kstep, voffB); PG8_STAGE(PG8_SA(1, 0), cA + kstep, voffA); PG8_STAGE(PG8_SB(1, 1), cB + hstepB + kstep, voffB);
        PG8_WAIT_V(6); PG8_BAR;
    }
    for (;;) {
        const bool has_next = S.next(ui + 1, nxt);
        const char* nA = has_next ? g.a_tile(nxt.pm) : cA; const char* nB = has_next ? (const char*)g.Bt + (size_t)nxt.pn * tstepB : cB;
        for (int t = 0; t < nt; t += 2) {
            const bool last = (t == nt - 2);
            const char* a1 = cA + (size_t)(t + 1) * kstep;
            const char* a2 = last ? nA : cA + (size_t)(t + 2) * kstep; const char* b2 = last ? nB : cB + (size_t)(t + 2) * kstep;
            const char* a3 = a2 + kstep; const char* b3 = b2 + kstep;
            if (last && has_next) S.a_ready(nxt);
            if constexpr (SP2) {
            PG8_LDB(B0, 0, 0); PG8_LDB(B1, 0, 1); PG8_SCHED; PG8_LDA(At, 0, 0); PG8_STAGE(PG8_SA(1, 1), a1 + hstepA, voffA);
            PG8_WAIT_V(8); PG8_WAIT_L(0); PG8_BAR; PG8_MMA(0, 0, At, B0); PG8_MMA(0, 1, At, B1); PG8_BAR; PG8_SCHED;
            PG8_LDA(At, 0, 1); PG8_STAGE(PG8_SB(0, 0), b2, voffB); PG8_STAGE(PG8_SB(0, 1), b2 + hstepB, voffB); PG8_STAGE(PG8_SA(0, 0), a2, voffA);
            PG8_WAIT_V(8); PG8_WAIT_L(0); PG8_BAR; PG8_MMA(1, 0, At, B0); PG8_MMA(1, 1, At, B1); PG8_BAR; PG8_SCHED;
            PG8_LDB(B0, 1, 0); PG8_LDB(B1, 1, 1); PG8_SCHED; PG8_LDA(At, 1, 0); PG8_STAGE(PG8_SA(0, 1), a2 + hstepA, voffA);
            PG8_WAIT_V(8); PG8_WAIT_L(0); PG8_BAR; PG8_MMA(0, 0, At, B0); PG8_MMA(0, 1, At, B1); PG8_BAR; PG8_SCHED;
            PG8_LDA(At, 1, 1); PG8_STAGE(PG8_SB(1, 0), b3, voffB); PG8_STAGE(PG8_SB(1, 1), b3 + hstepB, voffB); PG8_STAGE(PG8_SA(1, 0), a3, voffA);
            PG8_WAIT_V(8); PG8_WAIT_L(0); PG8_BAR; PG8_MMA(1, 0, At, B0); PG8_MMA(1, 1, At, B1); PG8_BAR; PG8_SCHED;
            } else {
            PG8_LDB(B0, 0, 0); PG8_SCHED; PG8_LDA(At, 0, 0); PG8_STAGE(PG8_SA(1, 1), a1 + hstepA, voffA);
            PG8_WAIT_L(8); PG8_BAR; PG8_WAIT_L(0); PG8_MMA(0, 0, At, B0); PG8_BAR; PG8_SCHED;
            PG8_LDB(B1, 0, 1); PG8_STAGE(PG8_SB(0, 0), b2, voffB);
            PG8_BAR; PG8_WAIT_L(0); PG8_MMA(0, 1, At, B1); PG8_BAR;
            PG8_LDA(At, 0, 1); PG8_STAGE(PG8_SA(0, 0), a2, voffA);
            PG8_BAR; PG8_WAIT_L(0); PG8_MMA(1, 0, At, B0); PG8_BAR; PG8_SCHED;
            PG8_STAGE(PG8_SB(0, 1), b2 + hstepB, voffB);
            PG8_WAIT_V(6); PG8_BAR; PG8_MMA(1, 1, At, B1); PG8_BAR;
            PG8_LDB(B0, 1, 0); PG8_SCHED; PG8_LDA(At, 1, 0); PG8_STAGE(PG8_SA(0, 1), a2 + hstepA, voffA);
            PG8_WAIT_L(8); PG8_BAR; PG8_WAIT_L(0); PG8_MMA(0, 0, At, B0); PG8_BAR; PG8_SCHED;
            PG8_LDB(B1, 1, 1); PG8_STAGE(PG8_SB(1, 0), b3, voffB);
            PG8_BAR; PG8_WAIT_L(0); PG8_MMA(0, 1, At, B1); PG8_BAR;
            PG8_LDA(At, 1, 1); PG8_STAGE(PG8_SA(1, 0), a3, voffA);
            PG8_BAR; PG8_WAIT_L(0); PG8_MMA(1, 0, At, B0); PG8_BAR; PG8_SCHED;
            PG8_STAGE(PG8_SB(1, 1), b3 + hstepB, voffB);
            PG8_WAIT_V(6); PG8_BAR; PG8_MMA(1, 1, At, B1); PG8_BAR;
            }
        }
        if constexpr (ALIGN_EPI) { if (wr == 0) PG8_BAR; }
        if constexpr (!Epi::AFTER_DRAIN) { E(acc, cur, wr, wc, fr, fq); S.done(cur); }
        if (!has_next) break;
#pragma unroll
        for (int a = 0; a < 2; ++a)
#pragma unroll
            for (int b = 0; b < 2; ++b)
#pragma unroll
                for (int m = 0; m < 4; ++m)
#pragma unroll
                    for (int n = 0; n < 2; ++n) acc[a][b][m][n] = (f32x4){0.f, 0.f, 0.f, 0.f};
        cur = nxt; cA = nA; cB = nB; ++ui;
        if constexpr (ALIGN_EPI) { if (wr == 1) PG8_BAR; }
    }
    PG8_WAIT_V(0);
    if constexpr (!ALIGN_EPI) { if (wr == 0) PG8_BAR; }
    PG8_BAR;
    if constexpr (Epi::AFTER_DRAIN) { E.fused(acc, cur, wr, wc, fr, fq, lds, wid, lane); S.done(cur); }
#undef PG8_SA
#undef PG8_SB
#undef PG8_STAGE
#undef PG8_LDA
#undef PG8_LDB
#undef PG8_MMA
#undef PG8_WAIT_V
#undef PG8_WAIT_L
#undef PG8_BAR
#undef PG8_SCHED
}
}

constexpr int NWAVES = 8, NTHR = 512;
constexpr int BATCH = 4, SEQ = 4096, D = 1024, M = BATCH * SEQ, HD = 64, NH = 16, NFOX = 8, NMOBA = 8;
constexpr int IN_COLS = 3080, DFF = 2816, MOD6 = 6 * D;
constexpr int MOBA_BLK = 256, MOBA_NB = SEQ / MOBA_BLK;
constexpr float NORM_EPS = 1e-6f, GN_EPS = 64e-5f;
constexpr float C2 = 0.125f * 1.4426950408889634f;
constexpr float LOG2E = 1.4426950408889634f;

constexpr size_t MiB = 1u << 20;
constexpr size_t WS_CTL = 0, CTL_ZERO_BYTES = 1 * MiB;
constexpr size_t WS_MOD = 1 * MiB;
constexpr size_t WS_LSIG = WS_MOD + 256 * 1024;
constexpr size_t WS_CUM = WS_LSIG + 512 * 1024;
constexpr size_t WS_KMEAN = WS_CUM + 512 * 1024;
constexpr size_t WS_WO = 3 * MiB;
constexpr size_t WS_WF1IN = 5 * MiB;
constexpr size_t WS_WF1OUT = 16 * MiB;
constexpr size_t WS_WR = 22 * MiB, WS_WK = 24 * MiB, WS_WV = 26 * MiB;
constexpr size_t WS_WLD = 28 * MiB;
constexpr size_t WS_WW2 = 30 * MiB, WS_WA2 = WS_WW2 + 256 * 1024, WS_WG2 = WS_WW2 + 512 * 1024;
constexpr size_t WS_WQKV = 31 * MiB;
constexpr size_t WS_WOUT = 37 * MiB;
constexpr size_t WS_WF0IN = 39 * MiB;
constexpr size_t WS_WF0OUT = 50 * MiB;
constexpr size_t SLOT = 32 * MiB;
constexpr size_t WS_AM1 = 32 * MiB;
constexpr size_t WS_A0 = 64 * MiB, WS_A1 = 96 * MiB, WS_A2 = 128 * MiB, WS_A3 = 160 * MiB, WS_A4 = 192 * MiB, WS_A5 = 224 * MiB, WS_END = 256 * MiB;
constexpr size_t WS_XN1G = WS_A0 - 8192;
static_assert(WS_WF0OUT + (size_t)D * DFF * 2 <= WS_A0 && WS_WG2 + 512 * 1024 <= WS_WQKV && WS_WF1OUT + (size_t)D * DFF * 2 <= WS_WR, "d_ws map");

constexpr int CW_BAR = 4096;

constexpr int RING_OFF = 0, RING_BYTES = 131072;
constexpr int LDSCTL_OFF = RING_BYTES, MISC_OFF = LDSCTL_OFF + 320;
constexpr int LDS_BYTES = 147456;
static_assert(MISC_OFF + 128 <= LDS_BYTES, "LDS map");

#define GAS __attribute__((address_space(1)))
#define LAS __attribute__((address_space(3)))
typedef unsigned short bf16;
typedef unsigned v4u __attribute__((ext_vector_type(4)));
typedef float f32x4 __attribute__((ext_vector_type(4)));
typedef short bf16x8 __attribute__((ext_vector_type(8)));
typedef GAS unsigned gu32;
typedef GAS unsigned long long gu64;
#define RLX_AGENT __ATOMIC_RELAXED, __HIP_MEMORY_SCOPE_AGENT
#define LDS_WAIT() asm volatile("s_waitcnt lgkmcnt(0)" ::: "memory")
#define VM_WAIT() asm volatile("s_waitcnt vmcnt(0)" ::: "memory")
__device__ __forceinline__ unsigned long long rt() { return __builtin_amdgcn_s_memrealtime(); }
__device__ __forceinline__ unsigned f2bf(float f) { unsigned u = __builtin_bit_cast(unsigned, f); return (u + 0x7fffu + ((u >> 16) & 1u)) >> 16; }
__device__ __forceinline__ unsigned pk2(float lo, float hi) { return f2bf(lo) | (f2bf(hi) << 16); }

#define XB_TMO      128
#define XB_XCNT(j)  (256  + 64 * (j))
#define XB_XSUB(j)  (1280 + 64 * (j))
#define XB_XGEN(j)  (2304 + 64 * (j))
#define XB_TOP      3328
#define XB_TOPGEN   3392
#define XCD_BAR_WORDS 3456
#define XB_SPIN_CAP (1u << 18)

__device__ __forceinline__ unsigned xb_ld(unsigned* p)              { return __hip_atomic_load(p, __ATOMIC_RELAXED, __HIP_MEMORY_SCOPE_AGENT); }
__device__ __forceinline__ unsigned xb_add(unsigned* p, unsigned v) { return __hip_atomic_fetch_add(p, v, __ATOMIC_RELAXED, __HIP_MEMORY_SCOPE_AGENT); }
__device__ __forceinline__ unsigned xb_xcc_id() { return (unsigned)__builtin_amdgcn_s_getreg((3 << 11) | 20) & 0xFu; }
#define XB_SPIN(cond, bar) do { unsigned _sp = 0; while (cond) { __builtin_amdgcn_s_sleep(1); \
    if ((++_sp & 255u) == 0u) { if (xb_ld(&(bar)[XB_TMO])) break; if (_sp > XB_SPIN_CAP) { atomicAdd(&(bar)[XB_TMO], 1u); break; } } } } while (0)

struct XcdBarrier {
    unsigned* bar; unsigned x;
    volatile LAS unsigned* st;
};

__device__ __forceinline__ XcdBarrier xcd_barrier_post(unsigned* bar, volatile LAS unsigned* st) {
    XcdBarrier b; b.bar = bar; b.x = xb_xcc_id(); b.st = st;
    if (threadIdx.x == 0) (void)xb_add(&bar[XB_XCNT(b.x)], 1u);
    return b;
}
__device__ __forceinline__ void xcd_barrier_complete(unsigned* bar, unsigned x, unsigned& nloc, unsigned& nx) {
    const unsigned G = gridDim.x * gridDim.y * gridDim.z;
    unsigned sum, cnt, mine, sp = 0u;
    for (;;) {
        sum = 0u; cnt = 0u; mine = 0u;
#pragma unroll
        for (unsigned j = 0; j < 16; ++j) { const unsigned c = xb_ld(&bar[XB_XCNT(j)]); sum += c; cnt += (c > 0u) ? 1u : 0u; mine = (j == x) ? c : mine; }
        if (sum == G) break;
        __builtin_amdgcn_s_sleep(1);
        if ((++sp & 255u) == 0u) { if (xb_ld(&bar[XB_TMO])) break; if (sp > XB_SPIN_CAP) { atomicAdd(&bar[XB_TMO], 1u); break; } }
    }
    nloc = mine > 0u ? mine : 1u; nx = cnt > 0u ? cnt : 1u;
}

__device__ __forceinline__ void xcd_barrier(const XcdBarrier& b) {
    asm volatile("s_waitcnt vmcnt(0)" ::: "memory");
    __syncthreads();
    if (threadIdx.x == 0) {
        unsigned* bar = b.bar;
        __builtin_amdgcn_s_waitcnt(0);
        unsigned nloc = b.st[0], nx = b.st[1];
        if (nloc == 0u) { xcd_barrier_complete(bar, b.x, nloc, nx); b.st[0] = nloc; b.st[1] = nx; }
        const unsigned old = xb_add(&bar[XB_XSUB(b.x)], 1u);
        const unsigned gen = old / nloc;
        if (old + 1u == (gen + 1u) * nloc) {
            __builtin_amdgcn_fence(__ATOMIC_RELEASE, "agent");
            asm volatile("s_waitcnt vmcnt(0)" ::: "memory");
            const unsigned og = xb_add(&bar[XB_TOP], 1u);
            const unsigned tg = og / nx;
            if (og + 1u == (tg + 1u) * nx) xb_add(&bar[XB_TOPGEN], 1u);
            else XB_SPIN(xb_ld(&bar[XB_TOPGEN]) == tg, bar);
            __builtin_amdgcn_fence(__ATOMIC_ACQUIRE, "agent");
            xb_add(&bar[XB_XGEN(b.x)], 1u);
            asm volatile("s_waitcnt vmcnt(0)" ::: "memory");
        } else {
            XB_SPIN(xb_ld(&bar[XB_XGEN(b.x)]) == gen, bar);
            __builtin_amdgcn_fence(__ATOMIC_ACQUIRE, "agent");
            asm volatile("s_waitcnt vmcnt(0)" ::: "memory");
        }
    }
    __syncthreads();
}

struct Frame {
    LAS unsigned char* lds;
    volatile LAS unsigned* MISC;
    gu32* ctl;
    int tid, lane, wave;
    int vcu, G;
    const float* const* in;
};
__device__ __forceinline__ float bf2f(unsigned short u) { return __uint_as_float((unsigned)u << 16); }
__device__ __forceinline__ float bflo(unsigned w) { return __uint_as_float(w << 16); }
__device__ __forceinline__ float bfhi(unsigned w) { return __uint_as_float(w & 0xffff0000u); }
__device__ __forceinline__ float wave_sum(float v) {
#pragma unroll
    for (int o = 1; o < 64; o <<= 1) v += __shfl_xor(v, o);
    return v;
}
__device__ __forceinline__ float wave_max(float v) {
#pragma unroll
    for (int o = 1; o < 64; o <<= 1) v = fmaxf(v, __shfl_xor(v, o));
    return v;
}
__device__ __forceinline__ float sigm(float x) { return 1.f / (1.f + __expf(-x)); }

__device__ __forceinline__ void p_mod(const Frame& F, const float* c, const float* mod_w, const float* mod_b, float* mod) {
    LAS float* cond = (LAS float*)(F.lds);
    LAS float* red = (LAS float*)(F.lds + 16384);
    for (int i = F.tid; i < BATCH * D; i += NTHR) { const float v = c[i]; cond[i] = v * sigm(v); }
    __syncthreads();
    for (int item = F.vcu; item < 2 * (MOD6 / 64); item += F.G) {
        const int l = item / (MOD6 / 64), n0 = (item % (MOD6 / 64)) * 64, col = n0 + F.lane, ks = F.wave;
        const float* wp = mod_w + ((size_t)l * D + ks * 128) * MOD6 + col;
        float a0 = 0.f, a1 = 0.f, a2 = 0.f, a3 = 0.f;
#pragma unroll 8
        for (int k = 0; k < 128; ++k) { const float w = wp[(size_t)k * MOD6]; const int kk = ks * 128 + k;
            a0 += cond[kk] * w; a1 += cond[D + kk] * w; a2 += cond[2 * D + kk] * w; a3 += cond[3 * D + kk] * w; }
        red[(ks * 4 + 0) * 64 + F.lane] = a0; red[(ks * 4 + 1) * 64 + F.lane] = a1; red[(ks * 4 + 2) * 64 + F.lane] = a2; red[(ks * 4 + 3) * 64 + F.lane] = a3;
        __syncthreads();
        if (F.tid < 256) { const int b = F.tid >> 6, cl = F.tid & 63; float s = 0.f;
#pragma unroll
            for (int k = 0; k < 8; ++k) s += red[(k * 4 + b) * 64 + cl];
            mod[((size_t)l * BATCH + b) * MOD6 + n0 + cl] = s + mod_b[(size_t)l * MOD6 + n0 + cl]; }
        __syncthreads();
    }
}

enum { RM_ID = 0, RM_QKV = 1, RM_SWIGLU = 2 };
__device__ __forceinline__ int rowmap(int mode, int n) {
    if (mode == RM_QKV) { const int i = n >> 9, j = n & 511; return (i % 3) * 1024 + (i / 3) * 512 + j; }
    if (mode == RM_SWIGLU) { const int up = n >= DFF, j = up ? n - DFF : n; return (j >> 7) * 256 + up * 128 + (j & 127); }
    return n;
}
__device__ __forceinline__ void transpose_item(const float* W, int ldw, int Ksrc, int k0, int n0, bf16* WT, int Kd, int kdst0, int rmode, int row_off,
                                               const float* mu, int mumode, LAS float* scr, int lane) {
#pragma unroll 8
    for (int i = 0; i < 32; ++i) { const int kk = 2 * i + (lane >> 5), k = k0 + kk; float v = 0.f;
        if (k < Ksrc) { v = W[(size_t)k * ldw + n0 + (lane & 31)]; if (mumode == 1) v *= mu[k]; else if (mumode == 2) v *= (1.f - mu[k]); }
        scr[kk * 33 + (lane & 31)] = v; }
    LDS_WAIT(); asm volatile("" ::: "memory");
    const int c = lane & 7;
#pragma unroll
    for (int j = 0; j < 4; ++j) { const int n = (lane >> 3) + 8 * j; const LAS float* s = scr + (8 * c) * 33 + n;
        v4u o; o.x = pk2(s[0 * 33], s[1 * 33]); o.y = pk2(s[2 * 33], s[3 * 33]); o.z = pk2(s[4 * 33], s[5 * 33]); o.w = pk2(s[6 * 33], s[7 * 33]);
        *(GAS v4u*)(WT + (size_t)(row_off + rowmap(rmode, n0 + n)) * Kd + kdst0 + k0 + 8 * c) = o; }
    LDS_WAIT(); asm volatile("" ::: "memory");
}
struct ConvJob { const float* W; int ldw, Ksrc, Kitems  , Nitems  ; bf16* WT; int Kd, kdst0, rmode, row_off; const float* mu; int mumode; };
__device__ __forceinline__ bool conv_run(const ConvJob& j, int& r, LAS float* scr, int lane) {
    const int cnt = j.Kitems * j.Nitems;
    if (r >= cnt) { r -= cnt; return false; }
    const int kb = r / j.Nitems, nb = r % j.Nitems;
    transpose_item(j.W, j.ldw, j.Ksrc, 64 * kb, 32 * nb, j.WT, j.Kd, j.kdst0, j.rmode, j.row_off, j.mu, j.mumode, scr, lane);
    return true;
}

__device__ __forceinline__ void norm_row(const float* xrow, bf16* orow, const float* g, const float* shift, const float* scale, int lane, f32x4 (&h)[4]) {
    const GAS f32x4* xr = (const GAS f32x4*)xrow + lane;
    f32x4 v[4]; float s = 0.f;
#pragma unroll
    for (int j = 0; j < 4; ++j) { v[j] = xr[64 * j]; s += (v[j].x * v[j].x + v[j].y * v[j].y) + (v[j].z * v[j].z + v[j].w * v[j].w); }
    const float inv = 1.f / sqrtf(wave_sum(s) * (1.f / D) + NORM_EPS);
    GAS unsigned long long* o8 = (GAS unsigned long long*)orow + lane;
#pragma unroll
    for (int j = 0; j < 4; ++j) { const int col = 4 * lane + 256 * j;
        const f32x4 gg = *(const f32x4*)(g + col), sh = *(const f32x4*)(shift + col), sc = *(const f32x4*)(scale + col);
        h[j] = (v[j] * inv * gg) * (1.f + sc) + sh;
        o8[64 * j] = (unsigned long long)pk2(h[j].x, h[j].y) | ((unsigned long long)pk2(h[j].z, h[j].w) << 32); }
}

__device__ __forceinline__ void attn_keys(const bf16* Kh, const bf16* Vh, int s_lo, int s_hi, const float* cum2, float ct, const float (&q)[64], float& m, float& l, float (&acc)[64], int lane) {
    for (int s = s_lo + lane; s < s_hi; s += 64) {
        const GAS v4u* kp = (const GAS v4u*)(Kh + (size_t)s * D);
        float dot = 0.f;
#pragma unroll
        for (int c = 0; c < 8; ++c) { const v4u w = kp[c];
            dot += q[8 * c + 0] * bflo(w.x) + q[8 * c + 1] * bfhi(w.x) + q[8 * c + 2] * bflo(w.y) + q[8 * c + 3] * bfhi(w.y)
                 + q[8 * c + 4] * bflo(w.z) + q[8 * c + 5] * bfhi(w.z) + q[8 * c + 6] * bflo(w.w) + q[8 * c + 7] * bfhi(w.w); }
        const float logit = dot + (cum2 ? ct - cum2[s] : 0.f);
        const float mn = fmaxf(m, logit), sc = __builtin_amdgcn_exp2f(m - mn), p = __builtin_amdgcn_exp2f(logit - mn);
        l = l * sc + p; m = mn;
        const GAS v4u* vp = (const GAS v4u*)(Vh + (size_t)s * D);
#pragma unroll
        for (int c = 0; c < 8; ++c) { const v4u w = vp[c];
            acc[8 * c + 0] = acc[8 * c + 0] * sc + p * bflo(w.x); acc[8 * c + 1] = acc[8 * c + 1] * sc + p * bfhi(w.x);
            acc[8 * c + 2] = acc[8 * c + 2] * sc + p * bflo(w.y); acc[8 * c + 3] = acc[8 * c + 3] * sc + p * bfhi(w.y);
            acc[8 * c + 4] = acc[8 * c + 4] * sc + p * bflo(w.z); acc[8 * c + 5] = acc[8 * c + 5] * sc + p * bfhi(w.z);
            acc[8 * c + 6] = acc[8 * c + 6] * sc + p * bflo(w.w); acc[8 * c + 7] = acc[8 * c + 7] * sc + p * bfhi(w.w); }
    }
}
__device__ __forceinline__ void attn_naive_item(int it, const bf16* Q, const bf16* K, const bf16* V, bf16* O, const float* cum2, const float* kmean, int lane) {
    const int mrow = it >> 4, h = it & 15, b = mrow / SEQ, t = mrow % SEQ;
    float q[64];
    { const GAS v4u* qp = (const GAS v4u*)(Q + (size_t)mrow * D + h * HD);
#pragma unroll
      for (int c = 0; c < 8; ++c) { const v4u w = qp[c]; q[8 * c] = bflo(w.x); q[8 * c + 1] = bfhi(w.x); q[8 * c + 2] = bflo(w.y); q[8 * c + 3] = bfhi(w.y);
          q[8 * c + 4] = bflo(w.z); q[8 * c + 5] = bfhi(w.z); q[8 * c + 6] = bflo(w.w); q[8 * c + 7] = bfhi(w.w); } }
    float m = -INFINITY, l = 0.f, acc[64];
#pragma unroll
    for (int d = 0; d < 64; ++d) acc[d] = 0.f;
    const bf16* Kh = K + (size_t)b * SEQ * D + h * HD; const bf16* Vh = V + (size_t)b * SEQ * D + h * HD;
    const float* cp = nullptr; float ct = 0.f; unsigned mask = 0u; int own_lo = 0;
    if (h < NFOX) { cp = cum2 + (size_t)(b * NFOX + h) * SEQ; ct = cp[t]; }
    else {
        const int qb = t >> 8; const float* km = kmean + (size_t)((b * NMOBA + (h - NFOX)) * MOBA_NB) * HD;
        float g = -INFINITY;
        if (lane < qb) { float s = 0.f; const float* kr = km + lane * HD;
#pragma unroll
            for (int d = 0; d < 64; ++d) s += q[d] * kr[d];
            g = s; }
        int rank = 0;
        for (int mm = 0; mm < MOBA_NB; ++mm) { const float gm = __shfl(g, mm); rank += (gm > g || (gm == g && mm < lane)) ? 1 : 0; }
        mask = (unsigned)__ballot(lane < qb && rank < 3) & 0xffffu; own_lo = 256 * qb;
    }
    for (;;) {
        int s_lo, s_hi; const bool last = (mask == 0u);
        if (!last) { const int j = __builtin_ctz(mask); mask &= mask - 1u; s_lo = 256 * j; s_hi = s_lo + 256; } else { s_lo = own_lo; s_hi = t + 1; }
        attn_keys(Kh, Vh, s_lo, s_hi, cp, ct, q, m, l, acc, lane);
        if (last) break;
    }
    const float mx = wave_max(m), w = __builtin_amdgcn_exp2f(m - mx), lt = wave_sum(l * w), il = 1.f / lt;
    float mine = 0.f;
#pragma unroll
    for (int d = 0; d < 64; ++d) { const float o = wave_sum(acc[d] * w); if (lane == d) mine = o; }
    O[(size_t)mrow * D + h * HD + lane] = (bf16)f2bf(mine * il);
}

__device__ __forceinline__ void scan_naive_chain(const Frame& F, int chain, const bf16* Rb, const bf16* Kb, const bf16* Vb, const bf16* LWb, const bf16* Ab, const bf16* Gb,
                                                 const float* w0, const float* a0, const float* k_k, const float* k_a, const float* r_k, const float* ln_w, const float* ln_b, bf16* Out) {
    const int b = chain >> 4, h = chain & 15, tid = F.tid, row = tid >> 3, sub = tid & 7;
    LAS float* sR = (LAS float*)F.lds; LAS float* sW = sR + 4096; LAS float* sK = sW + 4096; LAS float* sV = sK + 4096; LAS float* sA = sV + 4096; LAS float* sB = sA + 4096; LAS float* sY = sB + 4096;
    float S[8];
#pragma unroll
    for (int j = 0; j < 8; ++j) S[j] = 0.f;
    const int colh = h * HD + 8 * sub;
    float kkw[8], kaw[8], rkw[8], lnw[8], lnb[8], w0v[8], a0v[8];
#pragma unroll
    for (int j = 0; j < 8; ++j) { kkw[j] = k_k[colh + j]; kaw[j] = k_a[colh + j]; rkw[j] = r_k[colh + j]; lnw[j] = ln_w[colh + j]; lnb[j] = ln_b[colh + j]; w0v[j] = w0[colh + j]; a0v[j] = a0[colh + j]; }
    for (int ch = 0; ch < SEQ / 64; ++ch) {
        const size_t grow = (size_t)b * SEQ + ch * 64 + row;
        const size_t goff = grow * D + colh;
        {
            const v4u r8 = *(const GAS v4u*)(Rb + goff), k8 = *(const GAS v4u*)(Kb + goff), v8 = *(const GAS v4u*)(Vb + goff), w8 = *(const GAS v4u*)(LWb + goff), a8 = *(const GAS v4u*)(Ab + goff);
            float rr[8], kr[8], vv[8], lw[8], aa[8];
#define UNP(dst, src) dst[0] = bflo(src.x); dst[1] = bfhi(src.x); dst[2] = bflo(src.y); dst[3] = bfhi(src.y); dst[4] = bflo(src.z); dst[5] = bfhi(src.z); dst[6] = bflo(src.w); dst[7] = bfhi(src.w);
            UNP(rr, r8) UNP(kr, k8) UNP(vv, v8) UNP(lw, w8) UNP(aa, a8)
#pragma unroll
            for (int j = 0; j < 8; ++j) { lw[j] = -0.6065306597126334f * sigm(w0v[j] + lw[j]); aa[j] = sigm(a0v[j] + aa[j]); }
            float kkv[8], ss = 0.f;
#pragma unroll
            for (int j = 0; j < 8; ++j) { kkv[j] = kr[j] * kkw[j]; ss += kkv[j] * kkv[j]; }
            ss += __shfl_xor(ss, 1); ss += __shfl_xor(ss, 2); ss += __shfl_xor(ss, 4);
            const float inv = 1.f / fmaxf(sqrtf(ss), 1e-12f);
            const int lo = row * 64 + 8 * sub;
#pragma unroll
            for (int j = 0; j < 8; ++j) { const float kk = kkv[j] * inv;
                sR[lo + j] = rr[j]; sW[lo + j] = __expf(lw[j]); sK[lo + j] = kr[j] * (1.f + (aa[j] - 1.f) * kaw[j]); sV[lo + j] = vv[j]; sA[lo + j] = -kk; sB[lo + j] = kk * aa[j]; }
        }
        __syncthreads();
        for (int tt = 0; tt < 64; ++tt) {
            const int lo = tt * 64 + 8 * sub;
            const f32x4 a0 = *(const LAS f32x4*)(sA + lo), a1 = *(const LAS f32x4*)(sA + lo + 4), b0 = *(const LAS f32x4*)(sB + lo), b1 = *(const LAS f32x4*)(sB + lo + 4);
            const f32x4 w0 = *(const LAS f32x4*)(sW + lo), w1 = *(const LAS f32x4*)(sW + lo + 4), k0 = *(const LAS f32x4*)(sK + lo), k1 = *(const LAS f32x4*)(sK + lo + 4);
            const f32x4 r0 = *(const LAS f32x4*)(sR + lo), r1 = *(const LAS f32x4*)(sR + lo + 4);
            const float vi = sV[tt * 64 + row];
            float sa = (S[0] * a0.x + S[1] * a0.y) + (S[2] * a0.z + S[3] * a0.w) + (S[4] * a1.x + S[5] * a1.y) + (S[6] * a1.z + S[7] * a1.w);
            sa += __shfl_xor(sa, 1); sa += __shfl_xor(sa, 2); sa += __shfl_xor(sa, 4);
            S[0] = S[0] * w0.x + sa * b0.x + vi * k0.x; S[1] = S[1] * w0.y + sa * b0.y + vi * k0.y; S[2] = S[2] * w0.z + sa * b0.z + vi * k0.z; S[3] = S[3] * w0.w + sa * b0.w + vi * k0.w;
            S[4] = S[4] * w1.x + sa * b1.x + vi * k1.x; S[5] = S[5] * w1.y + sa * b1.y + vi * k1.y; S[6] = S[6] * w1.z + sa * b1.z + vi * k1.z; S[7] = S[7] * w1.w + sa * b1.w + vi * k1.w;
            float y = (S[0] * r0.x + S[1] * r0.y) + (S[2] * r0.z + S[3] * r0.w) + (S[4] * r1.x + S[5] * r1.y) + (S[6] * r1.z + S[7] * r1.w);
            y += __shfl_xor(y, 1); y += __shfl_xor(y, 2); y += __shfl_xor(y, 4);
            if (sub == 0) sY[tt * 64 + row] = y;
        }
        __syncthreads();
        {
            const int lo = row * 64 + 8 * sub; float y[8], s = 0.f, rk = 0.f;
#pragma unroll
            for (int j = 0; j < 8; ++j) { y[j] = sY[lo + j]; s += y[j]; rk += sR[lo + j] * sK[lo + j] * rkw[j]; }
            s += __shfl_xor(s, 1); s += __shfl_xor(s, 2); s += __shfl_xor(s, 4);
            rk += __shfl_xor(rk, 1); rk += __shfl_xor(rk, 2); rk += __shfl_xor(rk, 4);
            const float mean = s * (1.f / 64.f); float q = 0.f;
#pragma unroll
            for (int j = 0; j < 8; ++j) { const float d = y[j] - mean; q += d * d; }
            q += __shfl_xor(q, 1); q += __shfl_xor(q, 2); q += __shfl_xor(q, 4);
            const float rstd = 1.f / sqrtf(q * (1.f / 64.f) + GN_EPS);
            const v4u g8 = *(const GAS v4u*)(Gb + goff); float gg[8]; UNP(gg, g8)
            float o[8];
#pragma unroll
            for (int j = 0; j < 8; ++j) o[j] = ((y[j] - mean) * rstd * lnw[j] + lnb[j] + rk * sV[lo + j]) * gg[j];
            v4u w; w.x = pk2(o[0], o[1]); w.y = pk2(o[2], o[3]); w.z = pk2(o[4], o[5]); w.w = pk2(o[6], o[7]);
            *(GAS v4u*)(Out + goff) = w;
#undef UNP
        }
        __syncthreads();
    }
}

enum { I_X = 0, I_C, I_AWIN, I_ABF, I_AWOUT, I_MU, I_WR, I_WK, I_WV, I_WO, I_W0, I_W1, I_W2, I_A0, I_A1, I_A2, I_G1, I_G2, I_KK, I_KA, I_RK, I_LNW, I_LNB,
       I_MODW, I_MODB, I_NMIX, I_NFFN, I_FWIN, I_FWOUT, I_NFIN, N_IN };
enum { PH_PRO = 0, PH_NORM0, PH_QKV, PH_KMEAN, PH_ATTN, PH_WOUT, PH_NORMF0, PH_FFIN0, PH_FFOUT0, PH_NORM1, PH_MIX, PH_RKV, PH_LORAUP, PH_SCAN, PH_WO, PH_NORMF1, PH_FFIN1, PH_FFOUT1, PH_FINAL, N_PHASES };
struct Args { const float* in[N_IN]; float* out; unsigned char* ws; int ph_lo, ph_hi, pad0, pad1; };

template <class Epi> __device__ __forceinline__ void run_gemm(const Frame& F, const bf16* A, int lda, int gap, const bf16* Bt, int N, int K, const Epi& E) {
    asm volatile("" : "+s"(K), "+s"(lda));
    pg8::Gemm g{A, Bt, M, N, K, lda, gap}; pg8::StaticOrder S; S.init(M, N, F.G, (int)blockIdx.x);
    pg8::gemm_phase<Epi, pg8::StaticOrder, true, true>(F.lds + RING_OFF, g, S, E);
}

__global__ void __launch_bounds__(NTHR, 2) mk_fwd(Args args) {
    extern __shared__ __attribute__((aligned(16))) unsigned char lds[];
    Frame F;
    F.lds = (LAS unsigned char*)lds;
    F.MISC = (volatile LAS unsigned*)(F.lds + MISC_OFF);
    F.tid = threadIdx.x; F.lane = F.tid & 63; F.wave = __builtin_amdgcn_readfirstlane(F.tid >> 6);
    F.G = gridDim.x; { const int bx = blockIdx.x; F.vcu = (F.G % 8 == 0) ? (bx % 8) * (F.G / 8) + bx / 8 : bx; }
    unsigned char* ws = args.ws;
    F.ctl = (gu32*)(ws + WS_CTL);
    for (int u = F.tid; u < (LDS_BYTES - LDSCTL_OFF) / 4; u += NTHR) ((LAS unsigned*)(F.lds + LDSCTL_OFF))[u] = 0u;
    __syncthreads();
    XcdBarrier bar; bar.bar = (unsigned*)(F.ctl + CW_BAR); bar.x = 0; bar.st = nullptr;
#if MK_ONE_LAUNCH
    bar = xcd_barrier_post((unsigned*)(F.ctl + CW_BAR), F.MISC + 8);
#define GRID_BAR() xcd_barrier(bar)
#else
#define GRID_BAR() do { } while (0)
#endif
    const int lo = args.ph_lo, hi = args.ph_hi;
#ifndef PHMASK
#define PHMASK 0xffffffu
#endif
#define IN(k) ((((PHMASK) >> (k)) & 1u) && lo <= (k) && (k) < hi)
#define SEAM(k) do { if (IN(k) && IN((k) + 1)) GRID_BAR(); } while (0)
    const int gw = F.vcu * NWAVES + F.wave, NGW = F.G * NWAVES;
    const float* const* in = args.in;
    float* const mod = (float*)(ws + WS_MOD);
    float* const lsig = (float*)(ws + WS_LSIG);
    float* const cum2 = (float*)(ws + WS_CUM);
    float* const kmean = (float*)(ws + WS_KMEAN);
    float* const xres = args.out;
    bf16* const A0 = (bf16*)(ws + WS_A0); bf16* const A1 = (bf16*)(ws + WS_A1); bf16* const A2 = (bf16*)(ws + WS_A2); bf16* const A3 = (bf16*)(ws + WS_A3);
    bf16* const A4 = (bf16*)(ws + WS_A4); bf16* const A5 = (bf16*)(ws + WS_A5); bf16* const AM1 = (bf16*)(ws + WS_AM1); bf16* const XN1G = (bf16*)(ws + WS_XN1G);

    if (IN(PH_PRO)) {
        p_mod(F, in[I_C], in[I_MODW], in[I_MODB], mod);
        __syncthreads();
        LAS float* scr = (LAS float*)(F.lds + RING_OFF + F.wave * 16384);
        const float* mu = in[I_MU];
        int total = 0;
#define CJ_LIST(X) \
            X(in[I_AWIN], IN_COLS, D, 16, 96, WS_WQKV, D, 0, RM_QKV, 0, nullptr, 0) \
            X(in[I_AWOUT], D, D, 16, 32, WS_WOUT, D, 0, RM_ID, 0, nullptr, 0) \
            X(in[I_FWIN], 2 * DFF, D, 16, 176, WS_WF0IN, D, 0, RM_SWIGLU, 0, nullptr, 0) \
            X(in[I_FWIN] + (size_t)D * 2 * DFF, 2 * DFF, D, 16, 176, WS_WF1IN, D, 0, RM_SWIGLU, 0, nullptr, 0) \
            X(in[I_FWOUT], D, DFF, 44, 32, WS_WF0OUT, DFF, 0, RM_ID, 0, nullptr, 0) \
            X(in[I_FWOUT] + (size_t)DFF * D, D, DFF, 44, 32, WS_WF1OUT, DFF, 0, RM_ID, 0, nullptr, 0) \
            X(in[I_WR], D, D, 16, 32, WS_WR, D, 0, RM_ID, 0, nullptr, 0) \
            X(in[I_WK], D, D, 16, 32, WS_WK, D, 0, RM_ID, 0, nullptr, 0) \
            X(in[I_WV], D, D, 16, 32, WS_WV, D, 0, RM_ID, 0, nullptr, 0) \
            X(in[I_WO], D, D, 16, 32, WS_WO, D, 0, RM_ID, 0, nullptr, 0) \
            X(in[I_W1], 64, D, 16, 2, WS_WLD, 2 * D, 0, RM_ID, 0, mu + 1 * D, 1) \
            X(in[I_W1], 64, D, 16, 2, WS_WLD, 2 * D, D, RM_ID, 0, mu + 1 * D, 2) \
            X(in[I_A1], 64, D, 16, 2, WS_WLD, 2 * D, 0, RM_ID, 128, mu + 4 * D, 1) \
            X(in[I_A1], 64, D, 16, 2, WS_WLD, 2 * D, D, RM_ID, 128, mu + 4 * D, 2) \
            X(in[I_G1], 160, D, 16, 5, WS_WLD, 2 * D, 0, RM_ID, 256, mu + 5 * D, 1) \
            X(in[I_G1], 160, D, 16, 5, WS_WLD, 2 * D, D, RM_ID, 256, mu + 5 * D, 2) \
            X(in[I_W2], D, 64, 2, 32, WS_WW2, 128, 0, RM_ID, 0, nullptr, 0) \
            X(in[I_A2], D, 64, 2, 32, WS_WA2, 128, 0, RM_ID, 0, nullptr, 0) \
            X(in[I_G2], D, 160, 4, 32, WS_WG2, 256, 0, RM_ID, 0, nullptr, 0)
#define CJ_COUNT(W, ldw, Ks, Ki, Ni, WSO, Kd, kd0, rm, ro, mup, mm) total += (Ki) * (Ni);
        CJ_LIST(CJ_COUNT)
#define CJ_RUN(W, ldw, Ks, Ki, Ni, WSO, Kd, kd0, rm, ro, mup, mm) \
            if (r < (Ki) * (Ni)) { transpose_item(W, ldw, Ks, 64 * (r / (Ni)), 32 * (r % (Ni)), (bf16*)(ws + WSO), Kd, kd0, rm, ro, mup, mm, scr, F.lane); continue; } r -= (Ki) * (Ni);
        for (int it = gw; it < total; it += NGW) { int r = it;
            CJ_LIST(CJ_RUN) }
#undef CJ_LIST
#undef CJ_COUNT
#undef CJ_RUN
        { GAS v4u* wl = (GAS v4u*)(ws + WS_WLD); const v4u z = {0u, 0u, 0u, 0u};
          for (int i = blockIdx.x * NTHR + F.tid; i < 224 * 256; i += F.G * NTHR) { const int rr = i >> 8, c = i & 255; const int row = rr < 64 ? 64 + rr : (rr < 128 ? 192 + (rr - 64) : 416 + (rr - 128)); wl[(size_t)row * 256 + c] = z; } }
    }
    SEAM(PH_PRO);

    if (IN(PH_NORM0)) {
        LAS float* wf = (LAS float*)F.lds;
        for (int i = F.tid; i < D * 8; i += NTHR) wf[i] = in[I_AWIN][(size_t)(i >> 3) * IN_COLS + 3 * D + (i & 7)];
        __syncthreads();
        for (int m = gw; m < M; m += NGW) { const int b = m / SEQ; f32x4 h[4];
            const float* mb = mod + (size_t)b * MOD6;
            norm_row(in[I_X] + (size_t)m * D, A0 + (size_t)m * D, in[I_NMIX], mb, mb + D, F.lane, h);
            float f[8];
#pragma unroll
            for (int e = 0; e < 8; ++e) f[e] = 0.f;
#pragma unroll
            for (int j = 0; j < 4; ++j)
#pragma unroll
                for (int c = 0; c < 4; ++c) { const int col = 4 * F.lane + 256 * j + c; const float hv = h[j][c];
                    const f32x4 w0 = *(const LAS f32x4*)(wf + col * 8), w1 = *(const LAS f32x4*)(wf + col * 8 + 4);
                    f[0] += hv * w0.x; f[1] += hv * w0.y; f[2] += hv * w0.z; f[3] += hv * w0.w; f[4] += hv * w1.x; f[5] += hv * w1.y; f[6] += hv * w1.z; f[7] += hv * w1.w; }
            float mine = 0.f;
#pragma unroll
            for (int e = 0; e < 8; ++e) { const float s = wave_sum(f[e]); if (F.lane == e) mine = s; }
            if (F.lane < 8) { const float z = mine + in[I_ABF][F.lane]; const float ls = fminf(z, 0.f) - log1pf(__expf(-fabsf(z)));
                lsig[(size_t)(b * NFOX + F.lane) * SEQ + (m % SEQ)] = ls; }
        }
    }
    SEAM(PH_NORM0);

    if (IN(PH_QKV)) {
        if (gw < BATCH * NFOX) {
            const float* lp = lsig + (size_t)gw * SEQ + 64 * F.lane; double s = 0.0;
            for (int i = 0; i < 64; ++i) s += (double)lp[i];
            double pre = s;
#pragma unroll
            for (int o = 1; o < 64; o <<= 1) { const double t = __shfl_up(pre, o); if (F.lane >= o) pre += t; }
            double run = pre - s; float* cp = cum2 + (size_t)gw * SEQ + 64 * F.lane;
            for (int i = 0; i < 64; ++i) { run += (double)lp[i]; cp[i] = (float)(run * 1.4426950408889634); }
        }
        pg8::EpiBf16<0> E{A1, D, nullptr, D, (size_t)(WS_A2 - WS_A1) / 2, C2};
        run_gemm(F, A0, D, 0, (const bf16*)(ws + WS_WQKV), 3 * D, D, E);
    }
    SEAM(PH_QKV);

    if (IN(PH_KMEAN)) {
        for (int it = gw; it < BATCH * NMOBA * MOBA_NB; it += NGW) { const int n = it & 15, hm = (it >> 4) & 7, b = it >> 7;
            const bf16* kp = A2 + ((size_t)b * SEQ + n * MOBA_BLK) * D + (NFOX + hm) * HD + F.lane; float s = 0.f;
#pragma unroll 8
            for (int i = 0; i < MOBA_BLK; ++i) s += bf2f(kp[(size_t)i * D]);
            kmean[(size_t)it * HD + F.lane] = s * (1.f / MOBA_BLK); }
    }
    SEAM(PH_KMEAN);

    if (IN(PH_ATTN)) {
        for (int it = gw; it < M * NH; it += NGW) attn_naive_item(it, A1, A2, A3, A4, cum2, kmean, F.lane);
    }
    SEAM(PH_ATTN);

    if (IN(PH_WOUT)) { pg8::EpiResid E{in[I_X], xres, mod + 2 * D, MOD6}; run_gemm(F, A4, D, 0, (const bf16*)(ws + WS_WOUT), D, D, E); }
    SEAM(PH_WOUT);

#define FFN_PHASES(l, PHN, PHI, PHO, WIN, WOUT_) \
    if (IN(PHN)) { for (int m = gw; m < M; m += NGW) { f32x4 h[4]; const float* mb = mod + ((size_t)(l) * BATCH + m / SEQ) * MOD6; \
            norm_row(xres + (size_t)m * D, A0 + (size_t)m * D, in[I_NFFN] + (l) * D, mb + 3 * D, mb + 4 * D, F.lane, h); } } \
    SEAM(PHN); \
    if (IN(PHI)) { pg8::EpiSwiglu E{A1, DFF}; run_gemm(F, A0, D, 0, (const bf16*)(ws + WIN), 2 * DFF, D, E); } \
    SEAM(PHI); \
    if (IN(PHO)) { pg8::EpiResid E{xres, xres, mod + (size_t)(l) * BATCH * MOD6 + 5 * D, MOD6}; run_gemm(F, A1, DFF, 0, (const bf16*)(ws + WOUT_), D, DFF, E); } \
    SEAM(PHO);
    FFN_PHASES(0, PH_NORMF0, PH_FFIN0, PH_FFOUT0, WS_WF0IN, WS_WF0OUT)

    if (IN(PH_NORM1)) {
        if (blockIdx.x == 0) { const v4u z = {0u, 0u, 0u, 0u}; if (F.tid < 4 * 128) { const int b = F.tid >> 7, c = F.tid & 127; ((GAS v4u*)(XN1G + (size_t)b * (SEQ + 1) * D))[c] = z; } }
        for (int m = gw; m < M; m += NGW) { f32x4 h[4]; const int b = m / SEQ; const float* mb = mod + ((size_t)BATCH + b) * MOD6;
            norm_row(xres + (size_t)m * D, XN1G + ((size_t)b * (SEQ + 1) + 1 + (m % SEQ)) * D, in[I_NMIX] + D, mb, mb + D, F.lane, h); }
    }
    SEAM(PH_NORM1);

    if (IN(PH_MIX)) {
        const float* mu = in[I_MU];
        for (int m = gw; m < M; m += NGW) { const int b = m / SEQ; const bf16* hp = XN1G + ((size_t)b * (SEQ + 1) + (m % SEQ)) * D; const bf16* hc = hp + D;
#pragma unroll
            for (int j = 0; j < 4; ++j) { const int col = 4 * F.lane + 256 * j;
                const unsigned long long wc = *(const GAS unsigned long long*)(hc + col), wp = *(const GAS unsigned long long*)(hp + col);
                float c4[4] = {bflo((unsigned)wc), bfhi((unsigned)wc), bflo((unsigned)(wc >> 32)), bfhi((unsigned)(wc >> 32))};
                float p4[4] = {bflo((unsigned)wp), bfhi((unsigned)wp), bflo((unsigned)(wp >> 32)), bfhi((unsigned)(wp >> 32))};
                const f32x4 mr = *(const f32x4*)(mu + col), mk = *(const f32x4*)(mu + 2 * D + col), mv = *(const f32x4*)(mu + 3 * D + col);
                float xr[4], xk[4], xv[4];
#pragma unroll
                for (int e = 0; e < 4; ++e) { const float dx = p4[e] - c4[e]; xr[e] = c4[e] + dx * mr[e]; xk[e] = c4[e] + dx * mk[e]; xv[e] = c4[e] + dx * mv[e]; }
                const size_t o = (size_t)m * D + col;
                *(GAS unsigned long long*)(A1 + o) = (unsigned long long)pk2(xr[0], xr[1]) | ((unsigned long long)pk2(xr[2], xr[3]) << 32);
                *(GAS unsigned long long*)(A2 + o) = (unsigned long long)pk2(xk[0], xk[1]) | ((unsigned long long)pk2(xk[2], xk[3]) << 32);
                *(GAS unsigned long long*)(A3 + o) = (unsigned long long)pk2(xv[0], xv[1]) | ((unsigned long long)pk2(xv[2], xv[3]) << 32); } }
        __syncthreads();
        pg8::EpiBf16<1> E{A4, 512, nullptr, 0, 0, 1.f};
        run_gemm(F, XN1G, D, 1, (const bf16*)(ws + WS_WLD), 512, 2 * D, E);
    }
    SEAM(PH_MIX);

    if (IN(PH_RKV)) {
        { pg8::EpiBf16<0> E{A5, D, nullptr, 0, 0, 1.f}; run_gemm(F, A1, D, 0, (const bf16*)(ws + WS_WR), D, D, E); }
        { pg8::EpiBf16<0> E{A0, D, nullptr, 0, 0, 1.f}; run_gemm(F, A2, D, 0, (const bf16*)(ws + WS_WK), D, D, E); }
        { pg8::EpiBf16<0> E{AM1, D, nullptr, 0, 0, 1.f}; run_gemm(F, A3, D, 0, (const bf16*)(ws + WS_WV), D, D, E); }
    }
    SEAM(PH_RKV);

    if (IN(PH_LORAUP)) {
        { pg8::EpiBf16<0> E{A1, D, nullptr, 0, 0, 1.f}; run_gemm(F, A4, 512, 0, (const bf16*)(ws + WS_WW2), D, 128, E); }
        { pg8::EpiBf16<0> E{A2, D, nullptr, 0, 0, 1.f}; run_gemm(F, A4 + 128, 512, 0, (const bf16*)(ws + WS_WA2), D, 128, E); }
        { pg8::EpiBf16<0> E{A3, D, nullptr, 0, 0, 1.f}; run_gemm(F, A4 + 256, 512, 0, (const bf16*)(ws + WS_WG2), D, 256, E); }
    }
    SEAM(PH_LORAUP);

    if (IN(PH_SCAN)) {
        for (int chain = F.vcu; chain < BATCH * NH; chain += F.G)
            scan_naive_chain(F, chain, A5, A0, AM1, A1, A2, A3, in[I_W0], in[I_A0], in[I_KK], in[I_KA], in[I_RK], in[I_LNW], in[I_LNB], A4);
    }
    SEAM(PH_SCAN);

    if (IN(PH_WO)) { pg8::EpiResid E{xres, xres, mod + (size_t)BATCH * MOD6 + 2 * D, MOD6}; run_gemm(F, A4, D, 0, (const bf16*)(ws + WS_WO), D, D, E); }
    SEAM(PH_WO);

    FFN_PHASES(1, PH_NORMF1, PH_FFIN1, PH_FFOUT1, WS_WF1IN, WS_WF1OUT)

    if (IN(PH_FINAL)) {
        for (int m = gw; m < M; m += NGW) { GAS f32x4* xr = (GAS f32x4*)(xres + (size_t)m * D) + F.lane; f32x4 v[4]; float s = 0.f;
#pragma unroll
            for (int j = 0; j < 4; ++j) { v[j] = xr[64 * j]; s += (v[j].x * v[j].x + v[j].y * v[j].y) + (v[j].z * v[j].z + v[j].w * v[j].w); }
            const float inv = 1.f / sqrtf(wave_sum(s) * (1.f / D) + NORM_EPS);
#pragma unroll
            for (int j = 0; j < 4; ++j) { const f32x4 gg = *(const f32x4*)(in[I_NFIN] + 4 * F.lane + 256 * j); xr[64 * j] = v[j] * inv * gg; } }
    }
#undef IN
#undef SEAM
}

extern "C" void kernel_launch(void* const* d_in, const int* in_sizes, int n_in, void* d_out, int out_size, void* d_ws, size_t ws_size, hipStream_t stream) {
    static int grid = 0;
    if (grid == 0) {
        if (n_in != N_IN || in_sizes[0] != M * D || out_size != M * D || ws_size < WS_END) { fprintf(stderr, "kernel_launch: unexpected shapes (n_in %d, in0 %d, out %d, ws %zu); nothing launched\n", n_in, n_in > 0 ? in_sizes[0] : -1, out_size, ws_size); grid = -1; return; }
        int dev = 0, cus = 0, per_cu = 0;
        if (hipGetDevice(&dev) != hipSuccess || hipDeviceGetAttribute(&cus, hipDeviceAttributeMultiprocessorCount, dev) != hipSuccess) { grid = -1; return; }
        if (hipFuncSetAttribute((const void*)mk_fwd, hipFuncAttributeMaxDynamicSharedMemorySize, LDS_BYTES) != hipSuccess) { fprintf(stderr, "kernel_launch: hipFuncSetAttribute failed\n"); grid = -1; return; }
        if (hipOccupancyMaxActiveBlocksPerMultiprocessor(&per_cu, (const void*)mk_fwd, NTHR, LDS_BYTES) != hipSuccess || per_cu < 1) fprintf(stderr, "kernel_launch: note: occupancy query reports %d\n", per_cu);
        (void)hipGetLastError();
        grid = cus;
    }
    if (grid < 0) return;
    if (hipMemsetAsync((char*)d_ws + WS_CTL, 0, CTL_ZERO_BYTES, stream) != hipSuccess) { fprintf(stderr, "kernel_launch: memset failed\n"); return; }
    Args a{};
    for (int i = 0; i < N_IN; ++i) a.in[i] = (const float*)d_in[i];
    a.out = (float*)d_out; a.ws = (unsigned char*)d_ws;
#if MK_ONE_LAUNCH
    a.ph_lo = 0; a.ph_hi = N_PHASES;
    hipLaunchKernelGGL(mk_fwd, dim3(grid), dim3(NTHR), LDS_BYTES, stream, a);
#else
    for (int p = 0; p < N_PHASES; ++p) { a.ph_lo = p; a.ph_hi = p + 1; hipLaunchKernelGGL(mk_fwd, dim3(grid), dim3(NTHR), LDS_BYTES, stream, a); }
#endif
    const hipError_t le = hipPeekAtLastError();
    if (le != hipSuccess) fprintf(stderr, "kernel_launch: launch failed: %s\n", hipGetErrorName(le));
}
```

```cpp
#include <hip/hip_runtime.h>
#include <cstdio>
#include <cstdint>

#ifndef MK_ONE_LAUNCH
#define MK_ONE_LAUNCH 1
#endif

namespace pg8 {
#define PG8_LAS __attribute__((address_space(3)))
typedef unsigned short bf16_t;
typedef short bf16x8 __attribute__((ext_vector_type(8)));
typedef float f32x4 __attribute__((ext_vector_type(4)));
typedef unsigned u32x4 __attribute__((ext_vector_type(4)));
constexpr int BM = 256, BK = 64, HALF = 128, HTB = HALF * BK * 2  , STAGE_BYTES = 8 * HTB, NXCD = 8, WGM = 8;

__host__ __device__ __forceinline__ int lds_byte(int r, int c) { const int st = (r >> 4) * 2 + (c >> 5), rr = r & 15, cc = c & 31, ob = rr * 64 + cc * 2; return st * 1024 + (ob ^ (((ob >> 9) & 1) << 5)); }
__host__ __device__ __forceinline__ void stage_rc(int b, int& R, int& C) { const int st = b / 1024, sb = b % 1024, swz = sb ^ (((sb >> 9) & 1) << 5); R = (st >> 1) * 16 + swz / 64; C = (st & 1) * 32 + (swz % 64) / 2; }
__host__ __device__ __forceinline__ int perm32(int rho) { const int n = rho >> 4, i = rho & 15; return 8 * (i >> 2) + 4 * n + (i & 3); }

struct Unit { int pm, pn; };
struct Gemm { const bf16_t* A; const bf16_t* Bt; int M, N, K; int lda; int gap;
    __device__ __forceinline__ const char* a_tile(int pm) const { return (const char*)(A + ((size_t)pm * BM + (size_t)(pm >> 4) * gap) * lda); } };

struct StaticOrder {
    int nM, nN, nwg, G, c;
    __host__ __device__ void init(int M, int N, int G_, int c_) { nM = M / BM; nN = N / BM; nwg = nM * nN; G = G_; c = c_; }
    __host__ __device__ bool next(int i, Unit& u) const {
        const long L = (long)i * G + c; if (L >= nwg) return false;
        int wgid = (int)L; { const int q = nwg / NXCD, r = nwg % NXCD, xcd = wgid % NXCD, off = wgid / NXCD; wgid = (xcd < r ? xcd * (q + 1) : r * (q + 1) + (xcd - r) * q) + off; }
        const int nig = WGM * nN, gid = wgid / nig, fm = gid * WGM, gsz = (nM - fm) < WGM ? (nM - fm) : WGM;
        u.pm = fm + ((wgid % nig) % gsz); u.pn = (wgid % nig) / gsz; return true;
    }
    __device__ __forceinline__ void a_ready(const Unit&) const {}
    __device__ __forceinline__ void done(const Unit&) const {}
};

__device__ __forceinline__ unsigned cvt_pk_bf16(float lo, float hi) { unsigned r; asm volatile("v_cvt_pk_bf16_f32 %0, %1, %2" : "=v"(r) : "v"(lo), "v"(hi)); return r; }
__device__ __forceinline__ float sigmoidf_(float x) { return __builtin_amdgcn_rcpf(1.f + __expf(-x)); }
__device__ __forceinline__ float tanhf_(float x) { return 1.f - 2.f * __builtin_amdgcn_rcpf(__expf(2.f * x) + 1.f); }

template <int ACT> struct EpiBf16 {
    static constexpr bool PERM = true, AFTER_DRAIN = false;
    bf16_t* O; int ldc; const float* p; int split_cols; size_t split_stride; float scale0;
    __device__ __forceinline__ float act(float v, float pv, int col) const {
        if (ACT == 1) return col < 128 ? tanhf_(v) : (col < 256 ? v : sigmoidf_(v));
        if (ACT == 2) return -0.6065306597126334f * sigmoidf_(pv + v);
        if (ACT == 3) return sigmoidf_(pv + v);
        return v;
    }
    __device__ __forceinline__ void operator()(const f32x4 (&acc)[2][2][4][2], const Unit& u, int wr, int wc, int fr, int fq) const {
        const int row0 = u.pm * BM + wr * 64 + fr; int colt = u.pn * BM; bf16_t* base = O;
        float sc = 1.f; if (split_cols) { const int t = colt / split_cols; base += (size_t)t * split_stride; colt -= t * split_cols; if (t == 0) sc = scale0; }
        const int col0 = colt + wc * 32 + 8 * fq, bcol0 = u.pn * BM + wc * 32 + 8 * fq;
#pragma unroll
        for (int bj = 0; bj < 2; ++bj) {
            const int cb = bcol0 + bj * HALF;
            f32x4 p0 = {0.f, 0.f, 0.f, 0.f}, p1 = {0.f, 0.f, 0.f, 0.f};
            if (ACT >= 2) { p0 = *(const f32x4*)(p + cb); p1 = *(const f32x4*)(p + cb + 4); }
#pragma unroll
            for (int ai = 0; ai < 2; ++ai)
#pragma unroll
                for (int m = 0; m < 4; ++m) { bf16_t* rowp = base + (size_t)(row0 + ai * HALF + m * 16) * ldc + col0 + bj * HALF;
                    f32x4 v0 = acc[ai][bj][m][0], v1 = acc[ai][bj][m][1];
                    if (ACT != 0) {
#pragma unroll
                        for (int e = 0; e < 4; ++e) { v0[e] = act(v0[e], p0[e], cb + e); v1[e] = act(v1[e], p1[e], cb + 4 + e); } }
                    v0 = v0 * sc; v1 = v1 * sc; u32x4 w; w.x = cvt_pk_bf16(v0[0], v0[1]); w.y = cvt_pk_bf16(v0[2], v0[3]); w.z = cvt_pk_bf16(v1[0], v1[1]); w.w = cvt_pk_bf16(v1[2], v1[3]);
                    *(u32x4*)rowp = w;
                    if (ACT >= 2 && (m & 1)) asm volatile("" ::: "memory"); }
        }
    }
};
struct EpiSwiglu {
    static constexpr bool PERM = true, AFTER_DRAIN = false;
    bf16_t* O; int ldc;
    __device__ __forceinline__ void operator()(const f32x4 (&acc)[2][2][4][2], const Unit& u, int wr, int wc, int fr, int fq) const {
        const int row0 = u.pm * BM + wr * 64 + fr, col0 = u.pn * HALF + wc * 32 + 8 * fq;
#pragma unroll
        for (int ai = 0; ai < 2; ++ai)
#pragma unroll
            for (int m = 0; m < 4; ++m) { bf16_t* rowp = O + (size_t)(row0 + ai * HALF + m * 16) * ldc + col0; float h[8];
#pragma unroll
                for (int n = 0; n < 2; ++n)
#pragma unroll
                    for (int e = 0; e < 4; ++e) { const float g = acc[ai][0][m][n][e], up = acc[ai][1][m][n][e]; h[4 * n + e] = g * sigmoidf_(g) * up; }
                u32x4 w; w.x = cvt_pk_bf16(h[0], h[1]); w.y = cvt_pk_bf16(h[2], h[3]); w.z = cvt_pk_bf16(h[4], h[5]); w.w = cvt_pk_bf16(h[6], h[7]);
                *(u32x4*)rowp = w; }
    }
};
struct EpiResid {
    static constexpr bool PERM = false, AFTER_DRAIN = false;
    const float* base; float* out; const float* gate; int gstride;
    __device__ __forceinline__ void operator()(const f32x4 (&acc)[2][2][4][2], const Unit& u, int wr, int wc, int fr, int fq) const {
        const int row0 = u.pm * BM + wr * 64 + fr, col0 = u.pn * BM + wc * 32 + 4 * fq; const float* gp = gate + (size_t)(u.pm >> 4) * gstride + col0;
        f32x4 gv[2][2];
#pragma unroll
        for (int bj = 0; bj < 2; ++bj)
#pragma unroll
            for (int n = 0; n < 2; ++n) gv[bj][n] = *(const f32x4*)(gp + bj * HALF + n * 16);
#pragma unroll
        for (int ai = 0; ai < 2; ++ai)
#pragma unroll
            for (int m = 0; m < 4; ++m) { const size_t off = (size_t)(row0 + ai * HALF + m * 16) * 1024 + col0;
#pragma unroll
                for (int bj = 0; bj < 2; ++bj)
#pragma unroll
                    for (int n = 0; n < 2; ++n) { const f32x4 bs = *(const f32x4*)(base + off + bj * HALF + n * 16); *(f32x4*)(out + off + bj * HALF + n * 16) = bs + gv[bj][n] * acc[ai][bj][m][n]; } }
    }
};

template <class Epi, class Sched, bool ALIGN_EPI = false, bool SP2 = false>
__device__ __forceinline__ void gemm_phase(PG8_LAS unsigned char* lds, const Gemm g, const Sched& S, const Epi& E) {
    const int tid = threadIdx.x, wid = __builtin_amdgcn_readfirstlane(tid >> 6), lane = tid & 63, wr = wid >> 2, wc = wid & 3, fr = lane & 15, fq = lane >> 4;
    const int K = g.K, nt = K / BK;
    unsigned voffA[2], voffB[2];
#pragma unroll
    for (int i = 0; i < 2; ++i) { int R, C; stage_rc(tid * 16 + i * 8192, R, C); const int Rb = Epi::PERM ? ((R & ~31) + perm32(R & 31)) : R;
        voffA[i] = (unsigned)(R * g.lda + C) * 2u; voffB[i] = (unsigned)(Rb * K + C) * 2u; }
    const size_t kstep = (size_t)(BK * 2);
    const size_t hstepA = (size_t)HALF * g.lda * 2, hstepB = (size_t)HALF * K * 2;
    const size_t tstepB = 2 * hstepB;
    const unsigned ldsw = (unsigned)wid * 1024u;
    const int aoff = lds_byte(wr * 64 + fr, fq * 8), boff = lds_byte(wc * 32 + fr, fq * 8);
#define PG8_SA(b, h) (((b) * 2 + (h)) * HTB)
#define PG8_SB(b, h) ((4 + (b) * 2 + (h)) * HTB)
#define PG8_STAGE(bufoff, gbase, voff) do { _Pragma("unroll") for (int _i = 0; _i < 2; ++_i) \
        __builtin_amdgcn_global_load_lds((const unsigned*)((const char*)(gbase) + (voff)[_i]), (PG8_LAS unsigned*)(lds + (bufoff) + ldsw + _i * 8192), 16, 0, 0); } while (0)
#define PG8_LDA(dst, b, h) do { _Pragma("unroll") for (int m = 0; m < 4; ++m) _Pragma("unroll") for (int k = 0; k < 2; ++k) dst[m][k] = *(const PG8_LAS bf16x8*)(lds + PG8_SA(b, h) + aoff + m * 2048 + k * 1024); } while (0)
#define PG8_LDB(dst, b, h) do { _Pragma("unroll") for (int n = 0; n < 2; ++n) _Pragma("unroll") for (int k = 0; k < 2; ++k) dst[n][k] = *(const PG8_LAS bf16x8*)(lds + PG8_SB(b, h) + boff + n * 2048 + k * 1024); } while (0)
#define PG8_MMA(ai, bj, At, Bt) do { __builtin_amdgcn_s_setprio(1); _Pragma("unroll") for (int m = 0; m < 4; ++m) _Pragma("unroll") for (int n = 0; n < 2; ++n) _Pragma("unroll") for (int k = 0; k < 2; ++k) \
        acc[ai][bj][m][n] = __builtin_amdgcn_mfma_f32_16x16x32_bf16(Bt[n][k], At[m][k], acc[ai][bj][m][n], 0, 0, 0); __builtin_amdgcn_s_setprio(0); } while (0)
#define PG8_WAIT_V(n) asm volatile("s_waitcnt vmcnt(" #n ")" ::: "memory")
#define PG8_WAIT_L(n) asm volatile("s_waitcnt lgkmcnt(" #n ")" ::: "memory")
#define PG8_BAR __builtin_amdgcn_s_barrier()
#define PG8_SCHED __builtin_amdgcn_sched_barrier(0)
    Unit cur, nxt; int ui = 0;
    if (!S.next(0, cur)) return;
    f32x4 acc[2][2][4][2];
#pragma unroll
    for (int a = 0; a < 2; ++a)
#pragma unroll
        for (int b = 0; b < 2; ++b)
#pragma unroll
            for (int m = 0; m < 4; ++m)
#pragma unroll
                for (int n = 0; n < 2; ++n) acc[a][b][m][n] = (f32x4){0.f, 0.f, 0.f, 0.f};
    bf16x8 At[4][2], B0[2][2], B1[2][2];
    const char* cA = g.a_tile(cur.pm); const char* cB = (const char*)g.Bt + (size_t)cur.pn * tstepB;
    S.a_ready(cur);
    if constexpr (SP2) {
        PG8_STAGE(PG8_SB(0, 0), cB, voffB); PG8_STAGE(PG8_SB(0, 1), cB + hstepB, voffB); PG8_STAGE(PG8_SA(0, 0), cA, voffA); PG8_STAGE(PG8_SA(0, 1), cA + hstepA, voffA);
        if (wr == 1) PG8_BAR;
        PG8_WAIT_V(2); PG8_BAR;
        PG8_STAGE(PG8_SB(1, 0), cB + kstep, voffB); PG8_STAGE(PG8_SA(1, 0), cA + kstep, voffA); PG8_STAGE(PG8_SB(1, 1), cB + hstepB + kstep, voffB);
        PG8_WAIT_V(6); PG8_BAR;
    } else {
        PG8_STAGE(PG8_SB(0, 0), cB, voffB); PG8_STAGE(PG8_SA(0, 0), cA, voffA); PG8_STAGE(PG8_SB(0, 1), cB + hstepB, voffB); PG8_STAGE(PG8_SA(0, 1), cA + hstepA, voffA);
        if (wr == 1) PG8_BAR;
        PG8_WAIT_V(4); PG8_BAR;
        PG8_STAGE(PG8_SB(1, 0), cB + kstep, voffB); PG8_STAGE(PG8_SA(1, 0), cA + kstep, voffA); PG8_STAGE(PG8_SB(1, 1), cB + hstepB + kstep, voffB);
        PG8_WAIT_V(6); PG8_BAR;
    }
    for (;;) {
        const bool has_next = S.next(ui + 1, nxt);
        const char* nA = has_next ? g.a_tile(nxt.pm) : cA; const char* nB = has_next ? (const char*)g.Bt + (size_t)nxt.pn * tstepB : cB;
        for (int t = 0; t < nt; t += 2) {
            const bool last = (t == nt - 2);
            const char* a1 = cA + (size_t)(t + 1) * kstep;
            const char* a2 = last ? nA : cA + (size_t)(t + 2) * kstep; const char* b2 = last ? nB : cB + (size_t)(t + 2) * kstep;
            const char* a3 = a2 + kstep; const char* b3 = b2 + kstep;
            if (last && has_next) S.a_ready(nxt);
            if constexpr (SP2) {
            PG8_LDB(B0, 0, 0); PG8_LDB(B1, 0, 1); PG8_SCHED; PG8_LDA(At, 0, 0); PG8_STAGE(PG8_SA(1, 1), a1 + hstepA, voffA);
            PG8_WAIT_V(8); PG8_WAIT_L(0); PG8_BAR; PG8_MMA(0, 0, At, B0); PG8_MMA(0, 1, At, B1); PG8_BAR; PG8_SCHED;
            PG8_LDA(At, 0, 1); PG8_STAGE(PG8_SB(0, 0), b2, voffB); PG8_STAGE(PG8_SB(0, 1), b2 + hstepB, voffB); PG8_STAGE(PG8_SA(0, 0), a2, voffA);
            PG8_WAIT_V(8); PG8_WAIT_L(0); PG8_BAR; PG8_MMA(1, 0, At, B0); PG8_MMA(1, 1, At, B1); PG8_BAR; PG8_SCHED;
            PG8_LDB(B0, 1, 0); PG8_LDB(B1, 1, 1); PG8_SCHED; PG8_LDA(At, 1, 0); PG8_STAGE(PG8_SA(0, 1), a2 + hstepA, voffA);
            PG8_WAIT_V(8); PG8_WAIT_L(0); PG8_BAR; PG8_MMA(0, 0, At, B0); PG8_MMA(0, 1, At, B1); PG8_BAR; PG8_SCHED;
            PG8_LDA(At, 1, 1); PG8_STAGE(PG8_SB(1, 0), b3, voffB); PG8_STAGE(PG8_SB(1, 1), b3 + hstepB, voffB); PG8_STAGE(PG8_SA(1, 0), a3, voffA);
            PG8_WAIT_V(8); PG8_WAIT_L(0); PG8_BAR; PG8_MMA(1, 0, At, B0); PG8_MMA(1, 1, At, B1); PG8_BAR; PG8_SCHED;
            } else {
            PG8_LDB(B0, 0, 0); PG8_SCHED; PG8_LDA(At, 0, 0); PG8_STAGE(PG8_SA(1, 1), a1 + hstepA, voffA);
            PG8_WAIT_L(8); PG8_BAR; PG8_WAIT_L(0); PG8_MMA(0, 0, At, B0); PG8_BAR; PG8_SCHED;
            PG8_LDB(B1, 0, 1); PG8_STAGE(PG8_SB(0, 0), b2, voffB);
            PG8_BAR; PG8_WAIT_L(0); PG8_MMA(0, 1, At, B1); PG8_BAR;
            PG8_LDA(At, 0, 1); PG8_STAGE(PG8_SA(0, 0), a2, voffA);
            PG8_BAR; PG8_WAIT_L(0); PG8_MMA(1, 0, At, B0); PG8_BAR; PG8_SCHED;
            PG8_STAGE(PG8_SB(0, 1), b2 + hstepB, voffB);
            PG8_WAIT_V(6); PG8_BAR; PG8_MMA(1, 1, At, B1); PG8_BAR;
            PG8_LDB(B0, 1, 0); PG8_SCHED; PG8_LDA(At, 1, 0); PG8_STAGE(PG8_SA(0, 1), a2 + hstepA, voffA);
            PG8_WAIT_L(8); PG8_BAR; PG8_WAIT_L(0); PG8_MMA(0, 0, At, B0); PG8_BAR; PG8_SCHED;
            PG8_LDB(B1, 1, 1); PG8_STAGE(PG8_SB(1, 0), b3, voffB);
            PG8_BAR; PG8_WAIT_L(0); PG8_MMA(0, 1, At, B1); PG8_BAR;
            PG8_LDA(At, 1, 1); PG8_STAGE(PG8_SA(1, 0), a3, voffA);
            PG8_BAR; PG8_WAIT_L(0); PG8_MMA(1, 0, At, B0); PG8_BAR; PG8_SCHED;
            PG8_STAGE(PG8_SB(1, 1), b3 + hstepB, voffB);
            PG8_WAIT_V(6); PG8_BAR; PG8_MMA(1, 1, At, B1); PG8_BAR;
            }
        }
        if constexpr (ALIGN_EPI) { if (wr == 0) PG8_BAR; }
        if constexpr (!Epi::AFTER_DRAIN) { E(acc, cur, wr, wc, fr, fq); S.done(cur); }
        if (!has_next) break;
#pragma unroll
        for (int a = 0; a < 2; ++a)
#pragma unroll
            for (int b = 0; b < 2; ++b)
#pragma unroll
                for (int m = 0; m < 4; ++m)
#pragma unroll
                    for (int n = 0; n < 2; ++n) acc[a][b][m][n] = (f32x4){0.f, 0.f, 0.f, 0.f};
        cur = nxt; cA = nA; cB = nB; ++ui;
        if constexpr (ALIGN_EPI) { if (wr == 1) PG8_BAR; }
    }
    PG8_WAIT_V(0);
    if constexpr (!ALIGN_EPI) { if (wr == 0) PG8_BAR; }
    PG8_BAR;
    if constexpr (Epi::AFTER_DRAIN) { E.fused(acc, cur, wr, wc, fr, fq, lds, wid, lane); S.done(cur); }
#undef PG8_SA
#undef PG8_SB
#undef PG8_STAGE
#undef PG8_LDA
#undef PG8_LDB
#undef PG8_MMA
#undef PG8_WAIT_V
#undef PG8_WAIT_L
#undef PG8_BAR
#undef PG8_SCHED
}
}

constexpr int NWAVES = 8, NTHR = 512;
constexpr int BATCH = 4, SEQ = 4096, D = 1024, M = BATCH * SEQ, HD = 64, NH = 16, NFOX = 8, NMOBA = 8;
constexpr int IN_COLS = 3080, DFF = 2816, MOD6 = 6 * D;
constexpr int MOBA_BLK = 256, MOBA_NB = SEQ / MOBA_BLK;
constexpr float NORM_EPS = 1e-6f, GN_EPS = 64e-5f;
constexpr float C2 = 0.125f * 1.4426950408889634f;
constexpr float LOG2E = 1.4426950408889634f;

constexpr size_t MiB = 1u << 20;
constexpr size_t WS_CTL = 0, CTL_ZERO_BYTES = 1 * MiB;
constexpr size_t WS_MOD = 1 * MiB;
constexpr size_t WS_LSIG = WS_MOD + 256 * 1024;
constexpr size_t WS_CUM = WS_LSIG + 512 * 1024;
constexpr size_t WS_KMEAN = WS_CUM + 512 * 1024;
constexpr size_t WS_WO = 3 * MiB;
constexpr size_t WS_WF1IN = 5 * MiB;
constexpr size_t WS_WF1OUT = 16 * MiB;
constexpr size_t WS_WR = 22 * MiB, WS_WK = 24 * MiB, WS_WV = 26 * MiB;
constexpr size_t WS_WLD = 28 * MiB;
constexpr size_t WS_WW2 = 30 * MiB, WS_WA2 = WS_WW2 + 256 * 1024, WS_WG2 = WS_WW2 + 512 * 1024;
constexpr size_t WS_WQKV = 31 * MiB;
constexpr size_t WS_WOUT = 37 * MiB;
constexpr size_t WS_WF0IN = 39 * MiB;
constexpr size_t WS_WF0OUT = 50 * MiB;
constexpr size_t WS_XK = 56 * MiB, WS_XQ = 58 * MiB;
constexpr size_t SLOT = 32 * MiB;
constexpr size_t WS_AM1 = 32 * MiB;
constexpr size_t WS_A0 = 64 * MiB, WS_A1 = 96 * MiB, WS_A2 = 128 * MiB, WS_A3 = 160 * MiB, WS_A4 = 192 * MiB, WS_A5 = 224 * MiB, WS_END = 256 * MiB;
constexpr size_t WS_XN1G = WS_A0 - 8192;
static_assert(WS_WF0OUT + (size_t)D * DFF * 2 <= WS_A0 && WS_WG2 + 512 * 1024 <= WS_WQKV && WS_WF1OUT + (size_t)D * DFF * 2 <= WS_WR, "d_ws map");

constexpr int CW_BAR = 4096;

constexpr int RING_OFF = 0, RING_BYTES = 131072;
constexpr int LDSCTL_OFF = RING_BYTES, MISC_OFF = LDSCTL_OFF + 320;
constexpr int LDS_BYTES = 147456;
static_assert(MISC_OFF + 128 <= LDS_BYTES, "LDS map");

#define GAS __attribute__((address_space(1)))
#define LAS __attribute__((address_space(3)))
typedef unsigned short bf16;
typedef unsigned v4u __attribute__((ext_vector_type(4)));
typedef float f32x4 __attribute__((ext_vector_type(4)));
typedef short bf16x8 __attribute__((ext_vector_type(8)));
typedef GAS unsigned gu32;
typedef GAS unsigned long long gu64;
#define RLX_AGENT __ATOMIC_RELAXED, __HIP_MEMORY_SCOPE_AGENT
#define LDS_WAIT() asm volatile("s_waitcnt lgkmcnt(0)" ::: "memory")
#define VM_WAIT() asm volatile("s_waitcnt vmcnt(0)" ::: "memory")
__device__ __forceinline__ unsigned long long rt() { return __builtin_amdgcn_s_memrealtime(); }
__device__ __forceinline__ unsigned f2bf(float f) { unsigned u = __builtin_bit_cast(unsigned, f); return (u + 0x7fffu + ((u >> 16) & 1u)) >> 16; }
__device__ __forceinline__ unsigned pk2(float lo, float hi) { return f2bf(lo) | (f2bf(hi) << 16); }

#define XB_TMO      128
#define XB_XCNT(j)  (256  + 64 * (j))
#define XB_XSUB(j)  (1280 + 64 * (j))
#define XB_XGEN(j)  (2304 + 64 * (j))
#define XB_TOP      3328
#define XB_TOPGEN   3392
#define XCD_BAR_WORDS 3456
#define XB_SPIN_CAP (1u << 18)

__device__ __forceinline__ unsigned xb_ld(unsigned* p)              { return __hip_atomic_load(p, __ATOMIC_RELAXED, __HIP_MEMORY_SCOPE_AGENT); }
__device__ __forceinline__ unsigned xb_add(unsigned* p, unsigned v) { return __hip_atomic_fetch_add(p, v, __ATOMIC_RELAXED, __HIP_MEMORY_SCOPE_AGENT); }
__device__ __forceinline__ unsigned xb_xcc_id() { return (unsigned)__builtin_amdgcn_s_getreg((3 << 11) | 20) & 0xFu; }
#define XB_SPIN(cond, bar) do { unsigned _sp = 0; while (cond) { __builtin_amdgcn_s_sleep(1); \
    if ((++_sp & 255u) == 0u) { if (xb_ld(&(bar)[XB_TMO])) break; if (_sp > XB_SPIN_CAP) { atomicAdd(&(bar)[XB_TMO], 1u); break; } } } } while (0)

struct XcdBarrier {
    unsigned* bar; unsigned x;
    volatile LAS unsigned* st;
};

__device__ __forceinline__ XcdBarrier xcd_barrier_post(unsigned* bar, volatile LAS unsigned* st) {
    XcdBarrier b; b.bar = bar; b.x = xb_xcc_id(); b.st = st;
    if (threadIdx.x == 0) (void)xb_add(&bar[XB_XCNT(b.x)], 1u);
    return b;
}
__device__ __forceinline__ void xcd_barrier_complete(unsigned* bar, unsigned x, unsigned& nloc, unsigned& nx) {
    const unsigned G = gridDim.x * gridDim.y * gridDim.z;
    unsigned sum, cnt, mine, sp = 0u;
    for (;;) {
        sum = 0u; cnt = 0u; mine = 0u;
#pragma unroll
        for (unsigned j = 0; j < 16; ++j) { const unsigned c = xb_ld(&bar[XB_XCNT(j)]); sum += c; cnt += (c > 0u) ? 1u : 0u; mine = (j == x) ? c : mine; }
        if (sum == G) break;
        __builtin_amdgcn_s_sleep(1);
        if ((++sp & 255u) == 0u) { if (xb_ld(&bar[XB_TMO])) break; if (sp > XB_SPIN_CAP) { atomicAdd(&bar[XB_TMO], 1u); break; } }
    }
    nloc = mine > 0u ? mine : 1u; nx = cnt > 0u ? cnt : 1u;
}

__device__ __forceinline__ void xcd_barrier(const XcdBarrier& b) {
    asm volatile("s_waitcnt vmcnt(0)" ::: "memory");
    __syncthreads();
    if (threadIdx.x == 0) {
        unsigned* bar = b.bar;
        __builtin_amdgcn_s_waitcnt(0);
        unsigned nloc = b.st[0], nx = b.st[1];
        if (nloc == 0u) { xcd_barrier_complete(bar, b.x, nloc, nx); b.st[0] = nloc; b.st[1] = nx; }
        const unsigned old = xb_add(&bar[XB_XSUB(b.x)], 1u);
        const unsigned gen = old / nloc;
        if (old + 1u == (gen + 1u) * nloc) {
            __builtin_amdgcn_fence(__ATOMIC_RELEASE, "agent");
            asm volatile("s_waitcnt vmcnt(0)" ::: "memory");
            const unsigned og = xb_add(&bar[XB_TOP], 1u);
            const unsigned tg = og / nx;
            if (og + 1u == (tg + 1u) * nx) xb_add(&bar[XB_TOPGEN], 1u);
            else XB_SPIN(xb_ld(&bar[XB_TOPGEN]) == tg, bar);
            __builtin_amdgcn_fence(__ATOMIC_ACQUIRE, "agent");
            xb_add(&bar[XB_XGEN(b.x)], 1u);
            asm volatile("s_waitcnt vmcnt(0)" ::: "memory");
        } else {
            XB_SPIN(xb_ld(&bar[XB_XGEN(b.x)]) == gen, bar);
            __builtin_amdgcn_fence(__ATOMIC_ACQUIRE, "agent");
            asm volatile("s_waitcnt vmcnt(0)" ::: "memory");
        }
    }
    __syncthreads();
}

#include <hip/hip_bf16.h>
#include <cmath>
namespace attn_body {
using bf16=__hip_bfloat16;
using bf16x8=__attribute__((ext_vector_type(8)))short;
using s16x4=__attribute__((ext_vector_type(4)))short;
using f32x16=__attribute__((ext_vector_type(16)))float;
using u32x4=__attribute__((ext_vector_type(4)))unsigned;
constexpr int BATCH=4,NHEAD=16,SEQ=4096,D=64,DM=NHEAD*D;
constexpr int NW=8,QBLK=32,QB=QBLK*NW,KVBLK=64,NQB=SEQ/QB;
__device__ __forceinline__ int crow(int r,int hi){return (r&3)+8*(r>>2)+4*hi;}
#define SBAR() __builtin_amdgcn_sched_barrier(0)
__device__ __forceinline__ void cmask(f32x16&p0,f32x16&p1,int jb,int qrel,int hi){
  const float NEG=-INFINITY; int kb=64*jb+4*hi;
  #pragma unroll
  for(int r=0;r<16;++r){int kv=kb+(r&3)+8*(r>>2); if(kv>qrel)p0[r]=NEG; if(kv+32>qrel)p1[r]=NEG;}
}

constexpr int NSLOT=3, SLOTB=9216;
constexpr int LDS_K=0, LDS_V=NSLOT*SLOTB, LDS_WS=2*NSLOT*SLOTB, LDS_OST=LDS_WS+NW*64*4, LDS_BYTES=LDS_OST+NW*4096;
__device__ __forceinline__ void glds16(const void*gsrc,unsigned lds_dst){unsigned keep;
  asm volatile("s_mov_b32 %0, m0\n\ts_mov_b32 m0, %2\n\ts_nop 0\n\tglobal_load_lds_dwordx4 %1, off\n\ts_mov_b32 m0, %0":"=&s"(keep):"v"(gsrc),"s"(lds_dst):"memory");}
__device__ __forceinline__ float max3f(float a,float b,float c){float r;asm("v_max3_f32 %0, %1, %2, %3":"=v"(r):"v"(a),"v"(b),"v"(c));return r;}
__device__ __forceinline__ float max2f(float a,float b){float r;asm("v_max_f32_e32 %0, %1, %2":"=v"(r):"v"(a),"v"(b));return r;}
__device__ __forceinline__ float fadd_s(float a,float b){float r;asm("v_add_f32_e32 %0, %1, %2":"=v"(r):"v"(a),"v"(b));return r;}
__device__ __forceinline__ float fsub_s(float a,float b){float r;asm("v_sub_f32_e32 %0, %1, %2":"=v"(r):"v"(a),"v"(b));return r;}
typedef float f32x2_t __attribute__((ext_vector_type(2))); typedef __bf16 bf16x2_t __attribute__((ext_vector_type(2)));
__device__ __forceinline__ unsigned cvtpk_s(float lo,float hi){f32x2_t v={lo,hi};bf16x2_t b=__builtin_convertvector(v,bf16x2_t);return __builtin_bit_cast(unsigned,b);}
#define WAIT_BAR(N) asm volatile("s_waitcnt vmcnt(" #N ") lgkmcnt(0)\n\ts_barrier":::"memory")

template<bool FOX> __device__ __forceinline__ void qkt(f32x16&p0,f32x16&p1,const char*Kslot,const bf16x8*qr,const f32x16&negm,int r32,int hi){
  const char*kb=Kslot+hi*1024+r32*16;
  #pragma unroll
  for(int d0=0;d0<4;++d0){
    const bf16x8 b0=*reinterpret_cast<const bf16x8*>(kb+d0*2048);
    const bf16x8 b1=*reinterpret_cast<const bf16x8*>(kb+d0*2048+512);
    if(d0==0){p0=__builtin_amdgcn_mfma_f32_32x32x16_bf16(b0,qr[0],negm,0,0,0);p1=__builtin_amdgcn_mfma_f32_32x32x16_bf16(b1,qr[0],negm,0,0,0);}
    else{p0=__builtin_amdgcn_mfma_f32_32x32x16_bf16(b0,qr[d0],p0,0,0,0);p1=__builtin_amdgcn_mfma_f32_32x32x16_bf16(b1,qr[d0],p1,0,0,0);}}
  if(FOX){ const char*kx=Kslot+8192+r32*16;
    const bf16x8 b0=*reinterpret_cast<const bf16x8*>(kx); const bf16x8 b1=*reinterpret_cast<const bf16x8*>(kx+512);
    p0=__builtin_amdgcn_mfma_f32_32x32x16_bf16(b0,qr[4],p0,0,0,0);p1=__builtin_amdgcn_mfma_f32_32x32x16_bf16(b1,qr[4],p1,0,0,0);}
}
typedef __attribute__((address_space(3))) const char* lds_cptr;
typedef short v4i16_t __attribute__((ext_vector_type(4)));
#define LDSV8(p) (*(const __attribute__((address_space(3))) bf16x8*)(p))
template<bool FOX> __device__ __forceinline__ void kload_all(bf16x8*kf,lds_cptr kp,lds_cptr kx){
  kf[0]=LDSV8(kp);      kf[1]=LDSV8(kp+512);
  kf[2]=LDSV8(kp+2048); kf[3]=LDSV8(kp+2560);
  kf[4]=LDSV8(kp+4096); kf[5]=LDSV8(kp+4608);
  kf[6]=LDSV8(kp+6144); kf[7]=LDSV8(kp+6656);
  if(FOX){ kf[8]=LDSV8(kx); kf[9]=LDSV8(kx+512); }
}
__device__ __forceinline__ void kload2(bf16x8*kf,lds_cptr kp,int j){ kf[2*j]=LDSV8(kp+j*2048); kf[2*j+1]=LDSV8(kp+j*2048+512); }
__device__ __forceinline__ s16x4 vtr(lds_cptr p){ return __builtin_bit_cast(s16x4,__builtin_amdgcn_ds_read_tr16_b64_v4i16((__attribute__((address_space(3))) v4i16_t*)p)); }
__device__ __forceinline__ float rowmax(const f32x16&p0,const f32x16&p1){
  float a=max3f(p0[0],p0[1],p1[0]),b=max3f(p0[2],p0[3],p1[1]);a=max3f(a,p1[2],p1[3]);
  #pragma unroll
  for(int r=4;r<16;r+=4){a=max3f(a,p0[r],p0[r+1]);b=max3f(b,p0[r+2],p0[r+3]);a=max3f(a,p1[r],p1[r+1]);b=max3f(b,p1[r+2],p1[r+3]);}
  const float m=max2f(a,b);
  auto rr=__builtin_amdgcn_permlane32_swap(__float_as_uint(m),__float_as_uint(m),false,false);
  return max2f(__uint_as_float(rr[0]),__uint_as_float(rr[1]));
}
__device__ __forceinline__ void pv(f32x16*o,int vb,bf16x8 pa0,bf16x8 pa1,bf16x8 pa2,bf16x8 pa3){
  #pragma unroll
  for(int d0=0;d0<2;++d0){s16x4 lo[4],hi[4];
    #pragma unroll
    for(int ks=0;ks<4;++ks){
      asm volatile("ds_read_b64_tr_b16 %0,%1 offset:%c2":"=&v"(lo[ks]):"v"(vb),"i"(d0*4096+ks*1024):"memory");
      asm volatile("ds_read_b64_tr_b16 %0,%1 offset:%c2":"=&v"(hi[ks]):"v"(vb),"i"(d0*4096+ks*1024+512):"memory");}
    asm volatile("s_waitcnt lgkmcnt(0)":::"memory");SBAR();
    #define PK(k) (bf16x8){lo[k][0],lo[k][1],lo[k][2],lo[k][3],hi[k][0],hi[k][1],hi[k][2],hi[k][3]}
    o[d0]=__builtin_amdgcn_mfma_f32_32x32x16_bf16(pa0,PK(0),o[d0],0,0,0);
    o[d0]=__builtin_amdgcn_mfma_f32_32x32x16_bf16(pa1,PK(1),o[d0],0,0,0);
    o[d0]=__builtin_amdgcn_mfma_f32_32x32x16_bf16(pa2,PK(2),o[d0],0,0,0);
    o[d0]=__builtin_amdgcn_mfma_f32_32x32x16_bf16(pa3,PK(3),o[d0],0,0,0);
    #undef PK
  }
}

#ifndef ATTN_STORE16
#define ATTN_STORE16(p,v) (*(u32x4*)(p)=(v))
#endif
template<int THRL,bool FOX> __device__ __forceinline__ void attn_unit(int b,int h,int qb,const bf16*Q,const bf16*__restrict__ K,const bf16*__restrict__ V,bf16*O,char*shm,
                                                                      const bf16*__restrict__ XK,const bf16*__restrict__ XQ,const float*__restrict__ kmean){
  int tid_=threadIdx.x; asm volatile("":"+v"(tid_));
  const int tid=tid_,lane=tid&63,r32=lane&31,hi=lane>>5; const int wid=__builtin_amdgcn_readfirstlane(tid>>6);
  const long rowbase=(long)b*SEQ; const int q0=qb*QB;
  const bf16*Qw=Q+(rowbase+q0+wid*QBLK)*DM+h*D;
  const bf16*Kh=K+rowbase*DM+h*D,*Vh=V+rowbase*DM+h*D;
  const unsigned lds0=(unsigned)(uintptr_t)shm;
  float*wsf=(float*)(shm+LDS_WS)+wid*64;
  const bf16*ksrc=Kh+(long)lane*DM+wid*8;
  const bf16*vsrc=Vh+(long)(16*(wid&3)+(lane>>2))*DM+(wid>>2)*32+(lane&3)*8;
  const bf16*xsrc=FOX?XK+((long)(b*8+h)*SEQ+lane)*8:nullptr;
  const unsigned kdst=lds0+LDS_K+wid*1024, vdst=lds0+LDS_V+wid*1024, xdst=lds0+LDS_K+8192;
  #define PT(t) (FOX?(t):(((t)<4)?(4*qb+(t)):((t)-4)))
  #define DMA_K(t,slot) do{ glds16(ksrc+(long)PT(t)*KVBLK*DM,(unsigned)__builtin_amdgcn_readfirstlane(kdst+(slot))); \
                            if(FOX&&wid==0) glds16(xsrc+(long)PT(t)*KVBLK*8,(unsigned)__builtin_amdgcn_readfirstlane(xdst+(slot))); }while(0)
  #define DMA_V(t,slot) glds16(vsrc+(long)PT(t)*KVBLK*DM,(unsigned)__builtin_amdgcn_readfirstlane(vdst+(slot)))
  #define WAITX(N,HASK) do{ if(FOX&&(HASK)&&wid==0){ if((N)==2)WAIT_BAR(3); else if((N)==1)WAIT_BAR(2); else WAIT_BAR(1);} else { if((N)==2)WAIT_BAR(2); else if((N)==1)WAIT_BAR(1); else WAIT_BAR(0);} }while(0)
  const int vb0=(int)(lds0+LDS_V)+((lane>>4)&1)*32+(lane&3)*8+(4*hi+((lane&15)>>2))*64;
  const char*Kbase=shm+LDS_K; bf16x8 kf[FOX?10:8];
  const lds_cptr shm3=(lds_cptr)shm; const lds_cptr kp0=shm3+LDS_K+hi*1024+r32*16; const lds_cptr kx0=shm3+LDS_K+8192+r32*16; const lds_cptr vp0=shm3+LDS_V+((lane>>4)&1)*32+(lane&3)*8+(4*hi+((lane&15)>>2))*64;
  const int NT=(q0+QB)/KVBLK;
  DMA_K(0,0);DMA_V(0,0);DMA_K(1,SLOTB);
  bf16x8 qr[FOX?5:4];
  #pragma unroll
  for(int d0=0;d0<4;++d0)qr[d0]=*reinterpret_cast<const bf16x8*>(&Qw[(long)r32*DM+d0*16+hi*8]);
  if(FOX){ bf16x8 xq=*reinterpret_cast<const bf16x8*>(XQ+((long)(b*8+h)*SEQ+q0+wid*QBLK+r32)*8); if(hi)xq=(bf16x8){0,0,0,0,0,0,0,0}; qr[FOX?4:0]=xq; }
  unsigned msk=0u;
  if(!FOX){
    float qf[32];
    #pragma unroll
    for(int d0=0;d0<4;++d0)
      #pragma unroll
      for(int j=0;j<8;++j)qf[8*d0+j]=__uint_as_float(((unsigned)(unsigned short)qr[d0][j])<<16);
    float g[16];
    const float*km0=kmean+((long)(b*8+(h-8))*16)*64+8*hi;
    #pragma unroll
    for(int n=0;n<16;++n){ g[n]=-INFINITY;
      if(n<qb){ const float*km=km0+n*64; float s=0.f;
        #pragma unroll
        for(int d0=0;d0<4;++d0){ const float4 k0=*reinterpret_cast<const float4*>(km+16*d0), k1=*reinterpret_cast<const float4*>(km+16*d0+4);
          s+=qf[8*d0]*k0.x+qf[8*d0+1]*k0.y+qf[8*d0+2]*k0.z+qf[8*d0+3]*k0.w+qf[8*d0+4]*k1.x+qf[8*d0+5]*k1.y+qf[8*d0+6]*k1.z+qf[8*d0+7]*k1.w; }
        auto rr=__builtin_amdgcn_permlane32_swap(__float_as_uint(s),__float_as_uint(s),false,false);
        g[n]=__uint_as_float(rr[0])+__uint_as_float(rr[1]); } }
    #pragma unroll
    for(int n=0;n<16;++n){ int rank=0;
      #pragma unroll
      for(int m=0;m<16;++m) rank+=(g[m]>g[n]||(g[m]==g[n]&&m<n))?1:0;
      if(n<qb&&rank<3)msk|=(1u<<n); }
  }
  float mhat=0.f,l_reg=0.f,selb=0.f;f32x16 o[2];o[0]=f32x16{};o[1]=f32x16{};f32x16 negm;{float z_;asm volatile("v_mov_b32 %0, 0":"=v"(z_));
  #pragma unroll
  for(int r=0;r<16;++r)negm[r]=z_;}
  if(!FOX)asm volatile("":"+v"(negm));const f32x16 z16=f32x16{};
  const int qrel=wid*QBLK+r32;
  #define CMASK(P0,P1,t) do{ if(FOX){int jb_=(t)-(NT-4); if(jb_>=0)cmask(P0,P1,jb_,qrel,hi);} else { if((t)<4)cmask(P0,P1,(t),qrel,hi);} }while(0)
  #define BLKSEL(t) do{ if(!FOX&&(t)>=4&&(((t)&3)==0)){ selb=((msk>>(((t)-4)>>2))&1u)?0.f:-INFINITY; const float x_=selb-mhat; \
      _Pragma("unroll") for(int r=0;r<16;++r)negm[r]=x_; asm volatile("":"+v"(negm)); } }while(0)
  bool resc=false;
  #define SETREF() do{ if(FOX){ const float nm_=-mhat; const unsigned n1_=cvtpk_s(nm_,0.f)&0xffffu; const unsigned n2_=cvtpk_s(nm_-__uint_as_float(n1_<<16),0.f)&0xffffu; \
        if(hi==0){ qr[FOX?4:0][6]=(short)n1_; qr[FOX?4:0][7]=(short)n2_; } } \
      else { const float x_=selb-mhat; _Pragma("unroll") for(int r=0;r<16;++r)negm[r]=x_; asm volatile("":"+v"(negm)); } }while(0)
  #define START(P0,P1) do{ const float rm=rowmax(P0,P1); resc=false; \
    { const float dl=FOX?__builtin_ceilf(rm):rm; mhat=fadd_s(mhat,dl); \
      _Pragma("unroll") for(int r=0;r<16;++r){P0[r]=fsub_s(P0[r],dl);P1[r]=fsub_s(P1[r],dl);} \
      SETREF(); } \
    _Pragma("unroll") for(int r=0;r<16;++r)P0[r]=__builtin_amdgcn_exp2f(P0[r]); }while(0)
  #define RESC() do{ if(resc){ asm volatile("s_waitcnt lgkmcnt(0)":::"memory"); \
      _Pragma("unroll") for(int d_=0;d_<2;++d_) _Pragma("unroll") for(int r=0;r<16;++r)o[d_][r]*=wsf[crow(r,hi)]; } }while(0)
  f32x16 pA0,pA1,pB0,pB1;
  int sl_prev=0,sl_cur=0,sl_next=SLOTB;
  #define ROT() do{sl_prev=sl_cur;sl_cur=sl_next;sl_next=(sl_next==(NSLOT-1)*SLOTB)?0:sl_next+SLOTB;}while(0)
  DMA_K(2,2*SLOTB);
  WAIT_BAR(3);
  qkt<FOX>(pA0,pA1,Kbase,qr,(FOX?z16:negm),r32,hi);asm volatile("s_nop 15\n\ts_nop 7":"+v"(pA0),"+v"(pA1));CMASK(pA0,pA1,0);
  START(pA0,pA1);
  _Pragma("unroll") for(int r=0;r<16;++r)pA1[r]=__builtin_amdgcn_exp2f(pA1[r]);
  WAIT_BAR(0);
  DMA_K(3,0);DMA_V(1,SLOTB);
  ROT();
  kload_all<FOX>(kf,kp0+sl_cur,kx0+sl_cur);
  WAITX(2,true);
  s16x4 vlo[8],vhi[8]; u32x4 pw0,pw1,pw2,pw3;
  #define PKW(P,B) cvtpk_s(P[B],P[B+1])
  #define PAF(k) __builtin_bit_cast(bf16x8,pw##k)
  #define VFR(i) (bf16x8){vlo[i][0],vlo[i][1],vlo[i][2],vlo[i][3],vhi[i][0],vhi[i][1],vhi[i][2],vhi[i][3]}
  #define PIN(x) asm volatile("":"+v"(x))
  #define MX3(a,b,c) __builtin_fmaxf(__builtin_fmaxf((a),(b)),(c))
  #define GAPA(MF,A0,A1,A2,A3,W0,W1,PW) do{ MF; sacc+=A0; sacc+=A1; sacc+=A2; sacc+=A3; PIN(sacc); W0; W1; PIN(PW); SBAR(); }while(0)
  #define EX(v) __builtin_amdgcn_exp2f(v)
  #define GAPB(MF,X,B) do{ MF; X[B]=EX(X[B]); X[B+1]=EX(X[B+1]); X[B+2]=EX(X[B+2]); X[B+3]=EX(X[B+3]); PIN(X); SBAR(); }while(0)
  #define VRD(i) do{ vlo[i]=vtr(vp_+(((i)>>2)*4096+((i)&3)*1024)); vhi[i]=vtr(vp_+(((i)>>2)*4096+((i)&3)*1024+512)); }while(0)
  #define KRD(G,j) do{ if(G){ kload2(kf,kp0+sl_next,j); SBAR(); } }while(0)
  #define KRDX(G) do{ if(FOX&&(G)){ kf[FOX?8:0]=LDSV8(kx0+sl_next); kf[FOX?9:1]=LDSV8(kx0+sl_next+512); SBAR(); } }while(0)
  #define XMF(C0,C1) do{ if(FOX){ C0=__builtin_amdgcn_mfma_f32_32x32x16_bf16(kf[FOX?8:0],qr[FOX?4:0],C0,0,0,0); C1=__builtin_amdgcn_mfma_f32_32x32x16_bf16(kf[FOX?9:1],qr[FOX?4:0],C1,0,0,0); SBAR(); } }while(0)
  #define STEP(C0,C1,P0,P1,t,GK,GV,GL) do{ SBAR(); BLKSEL(t); \
    const lds_cptr vp_=vp0+sl_prev; \
    VRD(0); SBAR(); float sacc=(P0[0]+P0[1]); \
    GAPA(C0=__builtin_amdgcn_mfma_f32_32x32x16_bf16(kf[0],qr[0],(FOX?z16:negm),0,0,0), P0[2],P0[3],P0[4],P0[5],     pw0[0]=PKW(P0,0), pw0[1]=PKW(P0,2), pw0); \
    VRD(4); SBAR(); GAPA(C1=__builtin_amdgcn_mfma_f32_32x32x16_bf16(kf[1],qr[0],(FOX?z16:negm),0,0,0), P0[6],P0[7],P0[8],P0[9],     pw0[2]=PKW(P0,4), pw0[3]=PKW(P0,6), pw0); \
    VRD(1); SBAR(); GAPA(C0=__builtin_amdgcn_mfma_f32_32x32x16_bf16(kf[2],qr[1],C0,0,0,0),   P0[10],P0[11],P0[12],P0[13], pw1[0]=PKW(P0,8), pw1[1]=PKW(P0,10), pw1); \
    VRD(5); SBAR(); GAPA(C1=__builtin_amdgcn_mfma_f32_32x32x16_bf16(kf[3],qr[1],C1,0,0,0),   P0[14],P0[15],P1[0],P1[1],   pw1[2]=PKW(P0,12),pw1[3]=PKW(P0,14), pw1); \
    VRD(2); SBAR(); GAPA(C0=__builtin_amdgcn_mfma_f32_32x32x16_bf16(kf[4],qr[2],C0,0,0,0),   P1[2],P1[3],P1[4],P1[5],     pw2[0]=PKW(P1,0), pw2[1]=PKW(P1,2), pw2); \
    VRD(6); SBAR(); GAPA(C1=__builtin_amdgcn_mfma_f32_32x32x16_bf16(kf[5],qr[2],C1,0,0,0),   P1[6],P1[7],P1[8],P1[9],     pw2[2]=PKW(P1,4), pw2[3]=PKW(P1,6), pw2); \
    VRD(3); SBAR(); GAPA(C0=__builtin_amdgcn_mfma_f32_32x32x16_bf16(kf[6],qr[3],C0,0,0,0),   P1[10],P1[11],P1[12],P1[13], pw3[0]=PKW(P1,8), pw3[1]=PKW(P1,10), pw3); \
    VRD(7); SBAR(); GAPA(C1=__builtin_amdgcn_mfma_f32_32x32x16_bf16(kf[7],qr[3],C1,0,0,0),   P1[14],P1[15],0.f,0.f,       pw3[2]=PKW(P1,12),pw3[3]=PKW(P1,14), pw3); \
    XMF(C0,C1); \
    l_reg+=sacc; \
    if(GK){DMA_K((t)+3,sl_cur);} if(GV){DMA_V((t)+1,sl_next);} \
    CMASK(C0,C1,t); \
    { float a=MX3(C0[0],C0[1],C1[0]),b=MX3(C0[2],C0[3],C1[1]); a=MX3(a,C1[2],C1[3]); \
      _Pragma("unroll") for(int r=4;r<16;r+=4){a=MX3(a,C0[r],C0[r+1]);b=MX3(b,C0[r+2],C0[r+3]);a=MX3(a,C1[r],C1[r+1]);b=MX3(b,C1[r+2],C1[r+3]);} \
      float rm=__builtin_fmaxf(a,b); { auto rr=__builtin_amdgcn_permlane32_swap(__float_as_uint(rm),__float_as_uint(rm),false,false); rm=__builtin_fmaxf(__uint_as_float(rr[0]),__uint_as_float(rr[1])); } \
      resc=false; \
      if(__builtin_expect(__any(rm>(float)THRL),0)){ const float dl=FOX?__builtin_ceilf(__builtin_fmaxf(rm,0.f)):__builtin_fmaxf(rm,0.f); mhat+=dl; \
        _Pragma("unroll") for(int r=0;r<16;++r){C0[r]-=dl;C1[r]-=dl;} \
        SETREF(); \
        const float f=__builtin_amdgcn_exp2f(-dl); l_reg*=f; if(hi==0)wsf[r32]=f; resc=true; } } \
    SBAR(); \
    GAPB(o[0]=__builtin_amdgcn_mfma_f32_32x32x16_bf16(PAF(0),VFR(0),o[0],0,0,0), C0,0); \
    GAPB(o[1]=__builtin_amdgcn_mfma_f32_32x32x16_bf16(PAF(0),VFR(4),o[1],0,0,0), C0,4); \
    KRD(GL,0); GAPB(o[0]=__builtin_amdgcn_mfma_f32_32x32x16_bf16(PAF(1),VFR(1),o[0],0,0,0), C0,8); \
    KRD(GL,1); GAPB(o[1]=__builtin_amdgcn_mfma_f32_32x32x16_bf16(PAF(1),VFR(5),o[1],0,0,0), C0,12); \
    KRD(GL,2); GAPB(o[0]=__builtin_amdgcn_mfma_f32_32x32x16_bf16(PAF(2),VFR(2),o[0],0,0,0), C1,0); \
    KRD(GL,3); GAPB(o[1]=__builtin_amdgcn_mfma_f32_32x32x16_bf16(PAF(2),VFR(6),o[1],0,0,0), C1,4); \
    KRDX(GL); GAPB(o[0]=__builtin_amdgcn_mfma_f32_32x32x16_bf16(PAF(3),VFR(3),o[0],0,0,0), C1,8); \
    GAPB(o[1]=__builtin_amdgcn_mfma_f32_32x32x16_bf16(PAF(3),VFR(7),o[1],0,0,0), C1,12); \
    }while(0)
  int t=1;
  for(;t+5<NT;t+=2){
    STEP(pB0,pB1,pA0,pA1,t,true,true,true);     WAITX(2,true); RESC(); ROT();
    STEP(pA0,pA1,pB0,pB1,t+1,true,true,true);   WAITX(2,true); RESC(); ROT();
  }
  #define ENDW(tt) do{ if((tt)+3<NT){WAITX(2,true);} else if((tt)+2<NT){WAITX(1,false);} else {WAITX(0,false);} }while(0)
  for(;t+1<NT;t+=2){
    STEP(pB0,pB1,pA0,pA1,t,(t+3<NT),(t+1<NT),(t+1<NT));       ENDW(t);   RESC(); ROT();
    STEP(pA0,pA1,pB0,pB1,t+1,(t+4<NT),(t+2<NT),(t+2<NT));     ENDW(t+1); RESC(); ROT();
  }
  STEP(pB0,pB1,pA0,pA1,NT-1,false,false,false); RESC();
  { float sacc=pB0[0]+pB0[1]; _Pragma("unroll") for(int r=2;r<16;++r)sacc+=pB0[r]; _Pragma("unroll") for(int r=0;r<16;++r)sacc+=pB1[r]; l_reg+=sacc;
    pw0=(u32x4){PKW(pB0,0),PKW(pB0,2),PKW(pB0,4),PKW(pB0,6)};pw1=(u32x4){PKW(pB0,8),PKW(pB0,10),PKW(pB0,12),PKW(pB0,14)};pw2=(u32x4){PKW(pB1,0),PKW(pB1,2),PKW(pB1,4),PKW(pB1,6)};pw3=(u32x4){PKW(pB1,8),PKW(pB1,10),PKW(pB1,12),PKW(pB1,14)};
    SBAR(); pv(o,vb0+sl_cur,PAF(0),PAF(1),PAF(2),PAF(3)); }
  #undef PKW
  #undef PAF
  #undef VFR
  #undef PIN
  #undef MX3
  #undef GAPA
  #undef GAPB
  #undef EX
  #undef VRD
  #undef KRD
  #undef KRDX
  #undef XMF
  #undef STEP
  #undef ENDW
  {auto rr=__builtin_amdgcn_permlane32_swap(__float_as_uint(l_reg),__float_as_uint(l_reg),false,false);l_reg=__uint_as_float(rr[0])+__uint_as_float(rr[1]);}
  if(hi==0)wsf[32+r32]=l_reg;asm volatile("s_waitcnt lgkmcnt(0)":::"memory");
  float rli[16];
  #pragma unroll
  for(int r=0;r<16;++r)rli[r]=__builtin_amdgcn_rcpf(wsf[32+crow(r,hi)]);
  bf16*Ow=O+(rowbase+q0+wid*QBLK)*DM+h*D;
  { bf16*stg=(bf16*)(shm+LDS_OST)+wid*2048;
    #pragma unroll
    for(int r=0;r<16;++r){const int orow=crow(r,hi);
      #pragma unroll
      for(int d0=0;d0<2;++d0)stg[orow*64+d0*32+r32]=__float2bfloat16(o[d0][r]*rli[r]);}
    asm volatile("s_waitcnt lgkmcnt(0)":::"memory");
    #pragma unroll
    for(int i=0;i<4;++i){const int row=i*8+(lane>>3),ch=lane&7; const u32x4 v=*(const u32x4*)(stg+row*64+ch*8); ATTN_STORE16(Ow+(long)row*DM+ch*8,v);} }
  asm volatile("s_waitcnt lgkmcnt(0)\n\ts_barrier":::"memory");
  #undef DMA_K
  #undef DMA_V
  #undef PT
  #undef WAITX
  #undef CMASK
  #undef BLKSEL
  #undef START
  #undef SETREF
  #undef RESC
  #undef ROT
}
constexpr int ATTN_LDS_BYTES=LDS_BYTES;
template<int THRL=8> __device__ __forceinline__ void attn_phase(char*lds,int vcu,const bf16*Q,const bf16*K,const bf16*V,bf16*O,const bf16*XK,const bf16*XQ,const float*kmean){
  const int bh=(2*vcu)>>3, b=bh/NHEAD, h=bh%NHEAD;
  if(bh>=BATCH*NHEAD)return;
#if !defined(ATTN_ONLY_MOBA)
  if(h<8){ for(int i=0;i<4;++i){ const int s=(2*vcu+(i>>1))&7,qb=(i&1)?15-s:s; attn_unit<THRL,true>(b,h,qb,Q,K,V,O,lds,XK,XQ,kmean); } }
#endif
#if !defined(ATTN_ONLY_FOX)
  if(h>=8){ for(int i=0;i<4;++i){ const int s=(2*vcu+(i>>1))&7,qb=(i&1)?15-s:s; attn_unit<THRL,false>(b,h,qb,Q,K,V,O,lds,XK,XQ,kmean); } }
#endif
}
#undef SBAR
#undef WAIT_BAR
#undef LDSV8
}

struct Frame {
    LAS unsigned char* lds;
    volatile LAS unsigned* MISC;
    gu32* ctl;
    int tid, lane, wave;
    int vcu, G;
    const float* const* in;
};
__device__ __forceinline__ float bf2f(unsigned short u) { return __uint_as_float((unsigned)u << 16); }
__device__ __forceinline__ float bflo(unsigned w) { return __uint_as_float(w << 16); }
__device__ __forceinline__ float bfhi(unsigned w) { return __uint_as_float(w & 0xffff0000u); }
__device__ __forceinline__ float wave_sum(float v) {
#pragma unroll
    for (int o = 1; o < 64; o <<= 1) v += __shfl_xor(v, o);
    return v;
}
__device__ __forceinline__ float wave_max(float v) {
#pragma unroll
    for (int o = 1; o < 64; o <<= 1) v = fmaxf(v, __shfl_xor(v, o));
    return v;
}
__device__ __forceinline__ float sigm(float x) { return 1.f / (1.f + __expf(-x)); }

__device__ __forceinline__ void p_mod(const Frame& F, const float* c, const float* mod_w, const float* mod_b, float* mod) {
    LAS float* cond = (LAS float*)(F.lds);
    LAS float* red = (LAS float*)(F.lds + 16384);
    for (int i = F.tid; i < BATCH * D; i += NTHR) { const float v = c[i]; cond[i] = v * sigm(v); }
    __syncthreads();
    for (int item = F.vcu; item < 2 * (MOD6 / 64); item += F.G) {
        const int l = item / (MOD6 / 64), n0 = (item % (MOD6 / 64)) * 64, col = n0 + F.lane, ks = F.wave;
        const float* wp = mod_w + ((size_t)l * D + ks * 128) * MOD6 + col;
        float a0 = 0.f, a1 = 0.f, a2 = 0.f, a3 = 0.f;
#pragma unroll 8
        for (int k = 0; k < 128; ++k) { const float w = wp[(size_t)k * MOD6]; const int kk = ks * 128 + k;
            a0 += cond[kk] * w; a1 += cond[D + kk] * w; a2 += cond[2 * D + kk] * w; a3 += cond[3 * D + kk] * w; }
        red[(ks * 4 + 0) * 64 + F.lane] = a0; red[(ks * 4 + 1) * 64 + F.lane] = a1; red[(ks * 4 + 2) * 64 + F.lane] = a2; red[(ks * 4 + 3) * 64 + F.lane] = a3;
        __syncthreads();
        if (F.tid < 256) { const int b = F.tid >> 6, cl = F.tid & 63; float s = 0.f;
#pragma unroll
            for (int k = 0; k < 8; ++k) s += red[(k * 4 + b) * 64 + cl];
            mod[((size_t)l * BATCH + b) * MOD6 + n0 + cl] = s + mod_b[(size_t)l * MOD6 + n0 + cl]; }
        __syncthreads();
    }
}

enum { RM_ID = 0, RM_QKV = 1, RM_SWIGLU = 2 };
__device__ __forceinline__ int rowmap(int mode, int n) {
    if (mode == RM_QKV) { const int i = n >> 9, j = n & 511; return (i % 3) * 1024 + (i / 3) * 512 + j; }
    if (mode == RM_SWIGLU) { const int up = n >= DFF, j = up ? n - DFF : n; return (j >> 7) * 256 + up * 128 + (j & 127); }
    return n;
}
__device__ __forceinline__ void transpose_item(const float* W, int ldw, int Ksrc, int k0, int n0, bf16* WT, int Kd, int kdst0, int rmode, int row_off,
                                               const float* mu, int mumode, LAS float* scr, int lane) {
#pragma unroll 8
    for (int i = 0; i < 32; ++i) { const int kk = 2 * i + (lane >> 5), k = k0 + kk; float v = 0.f;
        if (k < Ksrc) { v = W[(size_t)k * ldw + n0 + (lane & 31)]; if (mumode == 1) v *= mu[k]; else if (mumode == 2) v *= (1.f - mu[k]); }
        scr[kk * 33 + (lane & 31)] = v; }
    LDS_WAIT(); asm volatile("" ::: "memory");
    const int c = lane & 7;
#pragma unroll
    for (int j = 0; j < 4; ++j) { const int n = (lane >> 3) + 8 * j; const LAS float* s = scr + (8 * c) * 33 + n;
        v4u o; o.x = pk2(s[0 * 33], s[1 * 33]); o.y = pk2(s[2 * 33], s[3 * 33]); o.z = pk2(s[4 * 33], s[5 * 33]); o.w = pk2(s[6 * 33], s[7 * 33]);
        *(GAS v4u*)(WT + (size_t)(row_off + rowmap(rmode, n0 + n)) * Kd + kdst0 + k0 + 8 * c) = o; }
    LDS_WAIT(); asm volatile("" ::: "memory");
}
struct ConvJob { const float* W; int ldw, Ksrc, Kitems  , Nitems  ; bf16* WT; int Kd, kdst0, rmode, row_off; const float* mu; int mumode; };
__device__ __forceinline__ bool conv_run(const ConvJob& j, int& r, LAS float* scr, int lane) {
    const int cnt = j.Kitems * j.Nitems;
    if (r >= cnt) { r -= cnt; return false; }
    const int kb = r / j.Nitems, nb = r % j.Nitems;
    transpose_item(j.W, j.ldw, j.Ksrc, 64 * kb, 32 * nb, j.WT, j.Kd, j.kdst0, j.rmode, j.row_off, j.mu, j.mumode, scr, lane);
    return true;
}

__device__ __forceinline__ void norm_row(const float* xrow, bf16* orow, const float* g, const float* shift, const float* scale, int lane, f32x4 (&h)[4]) {
    const GAS f32x4* xr = (const GAS f32x4*)xrow + lane;
    f32x4 v[4]; float s = 0.f;
#pragma unroll
    for (int j = 0; j < 4; ++j) { v[j] = xr[64 * j]; s += (v[j].x * v[j].x + v[j].y * v[j].y) + (v[j].z * v[j].z + v[j].w * v[j].w); }
    const float inv = 1.f / sqrtf(wave_sum(s) * (1.f / D) + NORM_EPS);
    GAS unsigned long long* o8 = (GAS unsigned long long*)orow + lane;
#pragma unroll
    for (int j = 0; j < 4; ++j) { const int col = 4 * lane + 256 * j;
        const f32x4 gg = *(const f32x4*)(g + col), sh = *(const f32x4*)(shift + col), sc = *(const f32x4*)(scale + col);
        h[j] = (v[j] * inv * gg) * (1.f + sc) + sh;
        o8[64 * j] = (unsigned long long)pk2(h[j].x, h[j].y) | ((unsigned long long)pk2(h[j].z, h[j].w) << 32); }
}

__device__ __forceinline__ void scan_naive_chain(const Frame& F, int chain, const bf16* Rb, const bf16* Kb, const bf16* Vb, const bf16* LWb, const bf16* Ab, const bf16* Gb,
                                                 const float* w0, const float* a0, const float* k_k, const float* k_a, const float* r_k, const float* ln_w, const float* ln_b, bf16* Out) {
    const int b = chain >> 4, h = chain & 15, tid = F.tid, row = tid >> 3, sub = tid & 7;
    LAS float* sR = (LAS float*)F.lds; LAS float* sW = sR + 4096; LAS float* sK = sW + 4096; LAS float* sV = sK + 4096; LAS float* sA = sV + 4096; LAS float* sB = sA + 4096; LAS float* sY = sB + 4096;
    float S[8];
#pragma unroll
    for (int j = 0; j < 8; ++j) S[j] = 0.f;
    const int colh = h * HD + 8 * sub;
    float kkw[8], kaw[8], rkw[8], lnw[8], lnb[8], w0v[8], a0v[8];
#pragma unroll
    for (int j = 0; j < 8; ++j) { kkw[j] = k_k[colh + j]; kaw[j] = k_a[colh + j]; rkw[j] = r_k[colh + j]; lnw[j] = ln_w[colh + j]; lnb[j] = ln_b[colh + j]; w0v[j] = w0[colh + j]; a0v[j] = a0[colh + j]; }
    for (int ch = 0; ch < SEQ / 64; ++ch) {
        const size_t grow = (size_t)b * SEQ + ch * 64 + row;
        const size_t goff = grow * D + colh;
        {
            const v4u r8 = *(const GAS v4u*)(Rb + goff), k8 = *(const GAS v4u*)(Kb + goff), v8 = *(const GAS v4u*)(Vb + goff), w8 = *(const GAS v4u*)(LWb + goff), a8 = *(const GAS v4u*)(Ab + goff);
            float rr[8], kr[8], vv[8], lw[8], aa[8];
#define UNP(dst, src) dst[0] = bflo(src.x); dst[1] = bfhi(src.x); dst[2] = bflo(src.y); dst[3] = bfhi(src.y); dst[4] = bflo(src.z); dst[5] = bfhi(src.z); dst[6] = bflo(src.w); dst[7] = bfhi(src.w);
            UNP(rr, r8) UNP(kr, k8) UNP(vv, v8) UNP(lw, w8) UNP(aa, a8)
#pragma unroll
            for (int j = 0; j < 8; ++j) { lw[j] = -0.6065306597126334f * sigm(w0v[j] + lw[j]); aa[j] = sigm(a0v[j] + aa[j]); }
            float kkv[8], ss = 0.f;
#pragma unroll
            for (int j = 0; j < 8; ++j) { kkv[j] = kr[j] * kkw[j]; ss += kkv[j] * kkv[j]; }
            ss += __shfl_xor(ss, 1); ss += __shfl_xor(ss, 2); ss += __shfl_xor(ss, 4);
            const float inv = 1.f / fmaxf(sqrtf(ss), 1e-12f);
            const int lo = row * 64 + 8 * sub;
#pragma unroll
            for (int j = 0; j < 8; ++j) { const float kk = kkv[j] * inv;
                sR[lo + j] = rr[j]; sW[lo + j] = __expf(lw[j]); sK[lo + j] = kr[j] * (1.f + (aa[j] - 1.f) * kaw[j]); sV[lo + j] = vv[j]; sA[lo + j] = -kk; sB[lo + j] = kk * aa[j]; }
        }
        __syncthreads();
        for (int tt = 0; tt < 64; ++tt) {
            const int lo = tt * 64 + 8 * sub;
            const f32x4 a0 = *(const LAS f32x4*)(sA + lo), a1 = *(const LAS f32x4*)(sA + lo + 4), b0 = *(const LAS f32x4*)(sB + lo), b1 = *(const LAS f32x4*)(sB + lo + 4);
            const f32x4 w0 = *(const LAS f32x4*)(sW + lo), w1 = *(const LAS f32x4*)(sW + lo + 4), k0 = *(const LAS f32x4*)(sK + lo), k1 = *(const LAS f32x4*)(sK + lo + 4);
            const f32x4 r0 = *(const LAS f32x4*)(sR + lo), r1 = *(const LAS f32x4*)(sR + lo + 4);
            const float vi = sV[tt * 64 + row];
            float sa = (S[0] * a0.x + S[1] * a0.y) + (S[2] * a0.z + S[3] * a0.w) + (S[4] * a1.x + S[5] * a1.y) + (S[6] * a1.z + S[7] * a1.w);
            sa += __shfl_xor(sa, 1); sa += __shfl_xor(sa, 2); sa += __shfl_xor(sa, 4);
            S[0] = S[0] * w0.x + sa * b0.x + vi * k0.x; S[1] = S[1] * w0.y + sa * b0.y + vi * k0.y; S[2] = S[2] * w0.z + sa * b0.z + vi * k0.z; S[3] = S[3] * w0.w + sa * b0.w + vi * k0.w;
            S[4] = S[4] * w1.x + sa * b1.x + vi * k1.x; S[5] = S[5] * w1.y + sa * b1.y + vi * k1.y; S[6] = S[6] * w1.z + sa * b1.z + vi * k1.z; S[7] = S[7] * w1.w + sa * b1.w + vi * k1.w;
            float y = (S[0] * r0.x + S[1] * r0.y) + (S[2] * r0.z + S[3] * r0.w) + (S[4] * r1.x + S[5] * r1.y) + (S[6] * r1.z + S[7] * r1.w);
            y += __shfl_xor(y, 1); y += __shfl_xor(y, 2); y += __shfl_xor(y, 4);
            if (sub == 0) sY[tt * 64 + row] = y;
        }
        __syncthreads();
        {
            const int lo = row * 64 + 8 * sub; float y[8], s = 0.f, rk = 0.f;
#pragma unroll
            for (int j = 0; j < 8; ++j) { y[j] = sY[lo + j]; s += y[j]; rk += sR[lo + j] * sK[lo + j] * rkw[j]; }
            s += __shfl_xor(s, 1); s += __shfl_xor(s, 2); s += __shfl_xor(s, 4);
            rk += __shfl_xor(rk, 1); rk += __shfl_xor(rk, 2); rk += __shfl_xor(rk, 4);
            const float mean = s * (1.f / 64.f); float q = 0.f;
#pragma unroll
            for (int j = 0; j < 8; ++j) { const float d = y[j] - mean; q += d * d; }
            q += __shfl_xor(q, 1); q += __shfl_xor(q, 2); q += __shfl_xor(q, 4);
            const float rstd = 1.f / sqrtf(q * (1.f / 64.f) + GN_EPS);
            const v4u g8 = *(const GAS v4u*)(Gb + goff); float gg[8]; UNP(gg, g8)
            float o[8];
#pragma unroll
            for (int j = 0; j < 8; ++j) o[j] = ((y[j] - mean) * rstd * lnw[j] + lnb[j] + rk * sV[lo + j]) * gg[j];
            v4u w; w.x = pk2(o[0], o[1]); w.y = pk2(o[2], o[3]); w.z = pk2(o[4], o[5]); w.w = pk2(o[6], o[7]);
            *(GAS v4u*)(Out + goff) = w;
#undef UNP
        }
        __syncthreads();
    }
}

enum { I_X = 0, I_C, I_AWIN, I_ABF, I_AWOUT, I_MU, I_WR, I_WK, I_WV, I_WO, I_W0, I_W1, I_W2, I_A0, I_A1, I_A2, I_G1, I_G2, I_KK, I_KA, I_RK, I_LNW, I_LNB,
       I_MODW, I_MODB, I_NMIX, I_NFFN, I_FWIN, I_FWOUT, I_NFIN, N_IN };
enum { PH_PRO = 0, PH_NORM0, PH_QKV, PH_KMEAN, PH_ATTN, PH_WOUT, PH_NORMF0, PH_FFIN0, PH_FFOUT0, PH_NORM1, PH_MIX, PH_RKV, PH_LORAUP, PH_SCAN, PH_WO, PH_NORMF1, PH_FFIN1, PH_FFOUT1, PH_FINAL, N_PHASES };
struct Args { const float* in[N_IN]; float* out; unsigned char* ws; int ph_lo, ph_hi, pad0, pad1; };

template <class Epi> __device__ __forceinline__ void run_gemm(const Frame& F, const bf16* A, int lda, int gap, const bf16* Bt, int N, int K, const Epi& E) {
    asm volatile("" : "+s"(K), "+s"(lda));
    pg8::Gemm g{A, Bt, M, N, K, lda, gap}; pg8::StaticOrder S; S.init(M, N, F.G, (int)blockIdx.x);
    pg8::gemm_phase<Epi, pg8::StaticOrder, true, true>(F.lds + RING_OFF, g, S, E);
}

__global__ void __launch_bounds__(NTHR, 2) mk_fwd(Args args) {
    extern __shared__ __attribute__((aligned(16))) unsigned char lds[];
    Frame F;
    F.lds = (LAS unsigned char*)lds;
    F.MISC = (volatile LAS unsigned*)(F.lds + MISC_OFF);
    F.tid = threadIdx.x; F.lane = F.tid & 63; F.wave = __builtin_amdgcn_readfirstlane(F.tid >> 6);
    F.G = gridDim.x; { const int bx = blockIdx.x; F.vcu = (F.G % 8 == 0) ? (bx % 8) * (F.G / 8) + bx / 8 : bx; }
    unsigned char* ws = args.ws;
    F.ctl = (gu32*)(ws + WS_CTL);
    for (int u = F.tid; u < (LDS_BYTES - LDSCTL_OFF) / 4; u += NTHR) ((LAS unsigned*)(F.lds + LDSCTL_OFF))[u] = 0u;
    __syncthreads();
    XcdBarrier bar; bar.bar = (unsigned*)(F.ctl + CW_BAR); bar.x = 0; bar.st = nullptr;
#if MK_ONE_LAUNCH
    bar = xcd_barrier_post((unsigned*)(F.ctl + CW_BAR), F.MISC + 8);
#define GRID_BAR() xcd_barrier(bar)
#else
#define GRID_BAR() do { } while (0)
#endif
    const int lo = args.ph_lo, hi = args.ph_hi;
#ifndef PHMASK
#define PHMASK 0xffffffu
#endif
#define IN(k) ((((PHMASK) >> (k)) & 1u) && lo <= (k) && (k) < hi)
#define SEAM(k) do { if (IN(k) && IN((k) + 1)) GRID_BAR(); } while (0)
    const int gw = F.vcu * NWAVES + F.wave, NGW = F.G * NWAVES;
    const float* const* in = args.in;
    float* const mod = (float*)(ws + WS_MOD);
    float* const lsig = (float*)(ws + WS_LSIG);
    float* const kmean = (float*)(ws + WS_KMEAN);
    float* const xres = args.out;
    bf16* const A0 = (bf16*)(ws + WS_A0); bf16* const A1 = (bf16*)(ws + WS_A1); bf16* const A2 = (bf16*)(ws + WS_A2); bf16* const A3 = (bf16*)(ws + WS_A3);
    bf16* const A4 = (bf16*)(ws + WS_A4); bf16* const A5 = (bf16*)(ws + WS_A5); bf16* const AM1 = (bf16*)(ws + WS_AM1); bf16* const XN1G = (bf16*)(ws + WS_XN1G);

    if (IN(PH_PRO)) {
        p_mod(F, in[I_C], in[I_MODW], in[I_MODB], mod);
        __syncthreads();
        LAS float* scr = (LAS float*)(F.lds + RING_OFF + F.wave * 16384);
        const float* mu = in[I_MU];
        int total = 0;
#define CJ_LIST(X) \
            X(in[I_AWIN], IN_COLS, D, 16, 96, WS_WQKV, D, 0, RM_QKV, 0, nullptr, 0) \
            X(in[I_AWOUT], D, D, 16, 32, WS_WOUT, D, 0, RM_ID, 0, nullptr, 0) \
            X(in[I_FWIN], 2 * DFF, D, 16, 176, WS_WF0IN, D, 0, RM_SWIGLU, 0, nullptr, 0) \
            X(in[I_FWIN] + (size_t)D * 2 * DFF, 2 * DFF, D, 16, 176, WS_WF1IN, D, 0, RM_SWIGLU, 0, nullptr, 0) \
            X(in[I_FWOUT], D, DFF, 44, 32, WS_WF0OUT, DFF, 0, RM_ID, 0, nullptr, 0) \
            X(in[I_FWOUT] + (size_t)DFF * D, D, DFF, 44, 32, WS_WF1OUT, DFF, 0, RM_ID, 0, nullptr, 0) \
            X(in[I_WR], D, D, 16, 32, WS_WR, D, 0, RM_ID, 0, nullptr, 0) \
            X(in[I_WK], D, D, 16, 32, WS_WK, D, 0, RM_ID, 0, nullptr, 0) \
            X(in[I_WV], D, D, 16, 32, WS_WV, D, 0, RM_ID, 0, nullptr, 0) \
            X(in[I_WO], D, D, 16, 32, WS_WO, D, 0, RM_ID, 0, nullptr, 0) \
            X(in[I_W1], 64, D, 16, 2, WS_WLD, 2 * D, 0, RM_ID, 0, mu + 1 * D, 1) \
            X(in[I_W1], 64, D, 16, 2, WS_WLD, 2 * D, D, RM_ID, 0, mu + 1 * D, 2) \
            X(in[I_A1], 64, D, 16, 2, WS_WLD, 2 * D, 0, RM_ID, 128, mu + 4 * D, 1) \
            X(in[I_A1], 64, D, 16, 2, WS_WLD, 2 * D, D, RM_ID, 128, mu + 4 * D, 2) \
            X(in[I_G1], 160, D, 16, 5, WS_WLD, 2 * D, 0, RM_ID, 256, mu + 5 * D, 1) \
            X(in[I_G1], 160, D, 16, 5, WS_WLD, 2 * D, D, RM_ID, 256, mu + 5 * D, 2) \
            X(in[I_W2], D, 64, 2, 32, WS_WW2, 128, 0, RM_ID, 0, nullptr, 0) \
            X(in[I_A2], D, 64, 2, 32, WS_WA2, 128, 0, RM_ID, 0, nullptr, 0) \
            X(in[I_G2], D, 160, 4, 32, WS_WG2, 256, 0, RM_ID, 0, nullptr, 0)
#define CJ_COUNT(W, ldw, Ks, Ki, Ni, WSO, Kd, kd0, rm, ro, mup, mm) total += (Ki) * (Ni);
        CJ_LIST(CJ_COUNT)
#define CJ_RUN(W, ldw, Ks, Ki, Ni, WSO, Kd, kd0, rm, ro, mup, mm) \
            if (r < (Ki) * (Ni)) { transpose_item(W, ldw, Ks, 64 * (r / (Ni)), 32 * (r % (Ni)), (bf16*)(ws + WSO), Kd, kd0, rm, ro, mup, mm, scr, F.lane); continue; } r -= (Ki) * (Ni);
        for (int it = gw; it < total; it += NGW) { int r = it;
            CJ_LIST(CJ_RUN) }
#undef CJ_LIST
#undef CJ_COUNT
#undef CJ_RUN
        { GAS v4u* wl = (GAS v4u*)(ws + WS_WLD); const v4u z = {0u, 0u, 0u, 0u};
          for (int i = blockIdx.x * NTHR + F.tid; i < 224 * 256; i += F.G * NTHR) { const int rr = i >> 8, c = i & 255; const int row = rr < 64 ? 64 + rr : (rr < 128 ? 192 + (rr - 64) : 416 + (rr - 128)); wl[(size_t)row * 256 + c] = z; } }
    }
    SEAM(PH_PRO);

    if (IN(PH_NORM0)) {
        LAS float* wf = (LAS float*)F.lds;
        for (int i = F.tid; i < D * 8; i += NTHR) wf[i] = in[I_AWIN][(size_t)(i >> 3) * IN_COLS + 3 * D + (i & 7)];
        __syncthreads();
        for (int m = gw; m < M; m += NGW) { const int b = m / SEQ; f32x4 h[4];
            const float* mb = mod + (size_t)b * MOD6;
            norm_row(in[I_X] + (size_t)m * D, A0 + (size_t)m * D, in[I_NMIX], mb, mb + D, F.lane, h);
            float f[8];
#pragma unroll
            for (int e = 0; e < 8; ++e) f[e] = 0.f;
#pragma unroll
            for (int j = 0; j < 4; ++j)
#pragma unroll
                for (int c = 0; c < 4; ++c) { const int col = 4 * F.lane + 256 * j + c; const float hv = h[j][c];
                    const f32x4 w0 = *(const LAS f32x4*)(wf + col * 8), w1 = *(const LAS f32x4*)(wf + col * 8 + 4);
                    f[0] += hv * w0.x; f[1] += hv * w0.y; f[2] += hv * w0.z; f[3] += hv * w0.w; f[4] += hv * w1.x; f[5] += hv * w1.y; f[6] += hv * w1.z; f[7] += hv * w1.w; }
            float mine = 0.f;
#pragma unroll
            for (int e = 0; e < 8; ++e) { const float s = wave_sum(f[e]); if (F.lane == e) mine = s; }
            if (F.lane < 8) { const float z = mine + in[I_ABF][F.lane]; const float ls = fminf(z, 0.f) - log1pf(__expf(-fabsf(z)));
                lsig[(size_t)(b * NFOX + F.lane) * SEQ + (m % SEQ)] = ls; }
        }
    }
    SEAM(PH_NORM0);

    if (IN(PH_QKV)) {
        if (gw < BATCH * NFOX) {
            const float* lp = lsig + (size_t)gw * SEQ + 64 * F.lane; double s = 0.0;
            for (int i = 0; i < 64; ++i) s += (double)lp[i];
            double pre = s;
#pragma unroll
            for (int o = 1; o < 64; o <<= 1) { const double t = __shfl_up(pre, o); if (F.lane >= o) pre += t; }
            double run = pre - s; GAS v4u* xk = (GAS v4u*)(ws + WS_XK) + (size_t)gw * SEQ + 64 * F.lane; GAS v4u* xq = (GAS v4u*)(ws + WS_XQ) + (size_t)gw * SEQ + 64 * F.lane;
            for (int i = 0; i < 64; ++i) { run += (double)lp[i];
                const float q = (float)(run * 1.4426950408889634), c = -q;
                const unsigned c1 = f2bf(c); const float r1 = c - __uint_as_float(c1 << 16); const unsigned c2 = f2bf(r1); const float r2 = r1 - __uint_as_float(c2 << 16); const unsigned c3 = f2bf(r2);
                const unsigned q1 = f2bf(q); const float s1 = q - __uint_as_float(q1 << 16); const unsigned q2 = f2bf(s1); const float s2 = s1 - __uint_as_float(q2 << 16); const unsigned q3 = f2bf(s2);
                v4u a; a.x = c1 | (c2 << 16); a.y = c3 | 0x3F800000u; a.z = 0x3F803F80u; a.w = 0x3F803F80u; xk[i] = a;
                v4u bq; bq.x = 0x3F803F80u; bq.y = 0x3F80u | (q1 << 16); bq.z = q2 | (q3 << 16); bq.w = 0u; xq[i] = bq; }
        }
        pg8::EpiBf16<0> E{A1, D, nullptr, D, (size_t)(WS_A2 - WS_A1) / 2, C2};
        run_gemm(F, A0, D, 0, (const bf16*)(ws + WS_WQKV), 3 * D, D, E);
    }
    SEAM(PH_QKV);

    if (IN(PH_KMEAN)) {
        for (int it = gw; it < BATCH * NMOBA * MOBA_NB; it += NGW) { const int n = it & 15, hm = (it >> 4) & 7, b = it >> 7;
            const bf16* kp = A2 + ((size_t)b * SEQ + n * MOBA_BLK) * D + (NFOX + hm) * HD + F.lane; float s = 0.f;
#pragma unroll 8
            for (int i = 0; i < MOBA_BLK; ++i) s += bf2f(kp[(size_t)i * D]);
            kmean[(size_t)it * HD + F.lane] = s * (1.f / MOBA_BLK); }
    }
    SEAM(PH_KMEAN);

    if (IN(PH_ATTN)) {
        attn_body::attn_phase<8>((char*)lds + RING_OFF, F.vcu, (const attn_body::bf16*)A1, (const attn_body::bf16*)A2, (const attn_body::bf16*)A3, (attn_body::bf16*)A4,
                                 (const attn_body::bf16*)(ws + WS_XK), (const attn_body::bf16*)(ws + WS_XQ), kmean);
    }
    SEAM(PH_ATTN);

    if (IN(PH_WOUT)) { pg8::EpiResid E{in[I_X], xres, mod + 2 * D, MOD6}; run_gemm(F, A4, D, 0, (const bf16*)(ws + WS_WOUT), D, D, E); }
    SEAM(PH_WOUT);

#define FFN_PHASES(l, PHN, PHI, PHO, WIN, WOUT_) \
    if (IN(PHN)) { for (int m = gw; m < M; m += NGW) { f32x4 h[4]; const float* mb = mod + ((size_t)(l) * BATCH + m / SEQ) * MOD6; \
            norm_row(xres + (size_t)m * D, A0 + (size_t)m * D, in[I_NFFN] + (l) * D, mb + 3 * D, mb + 4 * D, F.lane, h); } } \
    SEAM(PHN); \
    if (IN(PHI)) { pg8::EpiSwiglu E{A1, DFF}; run_gemm(F, A0, D, 0, (const bf16*)(ws + WIN), 2 * DFF, D, E); } \
    SEAM(PHI); \
    if (IN(PHO)) { pg8::EpiResid E{xres, xres, mod + (size_t)(l) * BATCH * MOD6 + 5 * D, MOD6}; run_gemm(F, A1, DFF, 0, (const bf16*)(ws + WOUT_), D, DFF, E); } \
    SEAM(PHO);
    FFN_PHASES(0, PH_NORMF0, PH_FFIN0, PH_FFOUT0, WS_WF0IN, WS_WF0OUT)

    if (IN(PH_NORM1)) {
        if (blockIdx.x == 0) { const v4u z = {0u, 0u, 0u, 0u}; if (F.tid < 4 * 128) { const int b = F.tid >> 7, c = F.tid & 127; ((GAS v4u*)(XN1G + (size_t)b * (SEQ + 1) * D))[c] = z; } }
        for (int m = gw; m < M; m += NGW) { f32x4 h[4]; const int b = m / SEQ; const float* mb = mod + ((size_t)BATCH + b) * MOD6;
            norm_row(xres + (size_t)m * D, XN1G + ((size_t)b * (SEQ + 1) + 1 + (m % SEQ)) * D, in[I_NMIX] + D, mb, mb + D, F.lane, h); }
    }
    SEAM(PH_NORM1);

    if (IN(PH_MIX)) {
        const float* mu = in[I_MU];
        for (int m = gw; m < M; m += NGW) { const int b = m / SEQ; const bf16* hp = XN1G + ((size_t)b * (SEQ + 1) + (m % SEQ)) * D; const bf16* hc = hp + D;
#pragma unroll
            for (int j = 0; j < 4; ++j) { const int col = 4 * F.lane + 256 * j;
                const unsigned long long wc = *(const GAS unsigned long long*)(hc + col), wp = *(const GAS unsigned long long*)(hp + col);
                float c4[4] = {bflo((unsigned)wc), bfhi((unsigned)wc), bflo((unsigned)(wc >> 32)), bfhi((unsigned)(wc >> 32))};
                float p4[4] = {bflo((unsigned)wp), bfhi((unsigned)wp), bflo((unsigned)(wp >> 32)), bfhi((unsigned)(wp >> 32))};
                const f32x4 mr = *(const f32x4*)(mu + col), mk = *(const f32x4*)(mu + 2 * D + col), mv = *(const f32x4*)(mu + 3 * D + col);
                float xr[4], xk[4], xv[4];
#pragma unroll
                for (int e = 0; e < 4; ++e) { const float dx = p4[e] - c4[e]; xr[e] = c4[e] + dx * mr[e]; xk[e] = c4[e] + dx * mk[e]; xv[e] = c4[e] + dx * mv[e]; }
                const size_t o = (size_t)m * D + col;
                *(GAS unsigned long long*)(A1 + o) = (unsigned long long)pk2(xr[0], xr[1]) | ((unsigned long long)pk2(xr[2], xr[3]) << 32);
                *(GAS unsigned long long*)(A2 + o) = (unsigned long long)pk2(xk[0], xk[1]) | ((unsigned long long)pk2(xk[2], xk[3]) << 32);
                *(GAS unsigned long long*)(A3 + o) = (unsigned long long)pk2(xv[0], xv[1]) | ((unsigned long long)pk2(xv[2], xv[3]) << 32); } }
        __syncthreads();
        pg8::EpiBf16<1> E{A4, 512, nullptr, 0, 0, 1.f};
        run_gemm(F, XN1G, D, 1, (const bf16*)(ws + WS_WLD), 512, 2 * D, E);
    }
    SEAM(PH_MIX);

    if (IN(PH_RKV)) {
        { pg8::EpiBf16<0> E{A5, D, nullptr, 0, 0, 1.f}; run_gemm(F, A1, D, 0, (const bf16*)(ws + WS_WR), D, D, E); }
        { pg8::EpiBf16<0> E{A0, D, nullptr, 0, 0, 1.f}; run_gemm(F, A2, D, 0, (const bf16*)(ws + WS_WK), D, D, E); }
        { pg8::EpiBf16<0> E{AM1, D, nullptr, 0, 0, 1.f}; run_gemm(F, A3, D, 0, (const bf16*)(ws + WS_WV), D, D, E); }
    }
    SEAM(PH_RKV);

    if (IN(PH_LORAUP)) {
        { pg8::EpiBf16<0> E{A1, D, nullptr, 0, 0, 1.f}; run_gemm(F, A4, 512, 0, (const bf16*)(ws + WS_WW2), D, 128, E); }
        { pg8::EpiBf16<0> E{A2, D, nullptr, 0, 0, 1.f}; run_gemm(F, A4 + 128, 512, 0, (const bf16*)(ws + WS_WA2), D, 128, E); }
        { pg8::EpiBf16<0> E{A3, D, nullptr, 0, 0, 1.f}; run_gemm(F, A4 + 256, 512, 0, (const bf16*)(ws + WS_WG2), D, 256, E); }
    }
    SEAM(PH_LORAUP);

    if (IN(PH_SCAN)) {
        for (int chain = F.vcu; chain < BATCH * NH; chain += F.G)
            scan_naive_chain(F, chain, A5, A0, AM1, A1, A2, A3, in[I_W0], in[I_A0], in[I_KK], in[I_KA], in[I_RK], in[I_LNW], in[I_LNB], A4);
    }
    SEAM(PH_SCAN);

    if (IN(PH_WO)) { pg8::EpiResid E{xres, xres, mod + (size_t)BATCH * MOD6 + 2 * D, MOD6}; run_gemm(F, A4, D, 0, (const bf16*)(ws + WS_WO), D, D, E); }
    SEAM(PH_WO);

    FFN_PHASES(1, PH_NORMF1, PH_FFIN1, PH_FFOUT1, WS_WF1IN, WS_WF1OUT)

    if (IN(PH_FINAL)) {
        for (int m = gw; m < M; m += NGW) { GAS f32x4* xr = (GAS f32x4*)(xres + (size_t)m * D) + F.lane; f32x4 v[4]; float s = 0.f;
#pragma unroll
            for (int j = 0; j < 4; ++j) { v[j] = xr[64 * j]; s += (v[j].x * v[j].x + v[j].y * v[j].y) + (v[j].z * v[j].z + v[j].w * v[j].w); }
            const float inv = 1.f / sqrtf(wave_sum(s) * (1.f / D) + NORM_EPS);
#pragma unroll
            for (int j = 0; j < 4; ++j) { const f32x4 gg = *(const f32x4*)(in[I_NFIN] + 4 * F.lane + 256 * j); xr[64 * j] = v[j] * inv * gg; } }
    }
#undef IN
#undef SEAM
}

extern "C" void kernel_launch(void* const* d_in, const int* in_sizes, int n_in, void* d_out, int out_size, void* d_ws, size_t ws_size, hipStream_t stream) {
    static int grid = 0;
    if (grid == 0) {
        if (n_in != N_IN || in_sizes[0] != M * D || out_size != M * D || ws_size < WS_END) { fprintf(stderr, "kernel_launch: unexpected shapes (n_in %d, in0 %d, out %d, ws %zu); nothing launched\n", n_in, n_in > 0 ? in_sizes[0] : -1, out_size, ws_size); grid = -1; return; }
        int dev = 0, cus = 0, per_cu = 0;
        if (hipGetDevice(&dev) != hipSuccess || hipDeviceGetAttribute(&cus, hipDeviceAttributeMultiprocessorCount, dev) != hipSuccess) { grid = -1; return; }
        if (hipFuncSetAttribute((const void*)mk_fwd, hipFuncAttributeMaxDynamicSharedMemorySize, LDS_BYTES) != hipSuccess) { fprintf(stderr, "kernel_launch: hipFuncSetAttribute failed\n"); grid = -1; return; }
        if (hipOccupancyMaxActiveBlocksPerMultiprocessor(&per_cu, (const void*)mk_fwd, NTHR, LDS_BYTES) != hipSuccess || per_cu < 1) fprintf(stderr, "kernel_launch: note: occupancy query reports %d\n", per_cu);
        (void)hipGetLastError();
        grid = cus;
    }
    if (grid < 0) return;
    if (hipMemsetAsync((char*)d_ws + WS_CTL, 0, CTL_ZERO_BYTES, stream) != hipSuccess) { fprintf(stderr, "kernel_launch: memset failed\n"); return; }
    Args a{};
    for (int i = 0; i < N_IN; ++i) a.in[i] = (const float*)d_in[i];
    a.out = (float*)d_out; a.ws = (unsigned char*)d_ws;
#if MK_ONE_LAUNCH
    a.ph_lo = 0; a.ph_hi = N_PHASES;
    hipLaunchKernelGGL(mk_fwd, dim3(grid), dim3(NTHR), LDS_BYTES, stream, a);
#else
    for (int p = 0; p < N_PHASES; ++p) { a.ph_lo = p; a.ph_hi = p + 1; hipLaunchKernelGGL(mk_fwd, dim3(grid), dim3(NTHR), LDS_BYTES, stream, a); }
#endif
    const hipError_t le = hipPeekAtLastError();
    if (le != hipSuccess) fprintf(stderr, "kernel_launch: launch failed: %s\n", hipGetErrorName(le));
}
```

```cpp
#include <hip/hip_runtime.h>
#include <cstdio>
#include <cstdint>

#ifndef MK_ONE_LAUNCH
#define MK_ONE_LAUNCH 1
#endif

namespace pg8 {
#define PG8_LAS __attribute__((address_space(3)))
typedef unsigned short bf16_t;
typedef short bf16x8 __attribute__((ext_vector_type(8)));
typedef float f32x4 __attribute__((ext_vector_type(4)));
typedef unsigned u32x4 __attribute__((ext_vector_type(4)));
constexpr int BM = 256, BK = 64, HALF = 128, HTB = HALF * BK * 2  , STAGE_BYTES = 8 * HTB, NXCD = 8, WGM = 8;

__host__ __device__ __forceinline__ int lds_byte(int r, int c) { const int st = (r >> 4) * 2 + (c >> 5), rr = r & 15, cc = c & 31, ob = rr * 64 + cc * 2; return st * 1024 + (ob ^ (((ob >> 9) & 1) << 5)); }
__host__ __device__ __forceinline__ void stage_rc(int b, int& R, int& C) { const int st = b / 1024, sb = b % 1024, swz = sb ^ (((sb >> 9) & 1) << 5); R = (st >> 1) * 16 + swz / 64; C = (st & 1) * 32 + (swz % 64) / 2; }
__host__ __device__ __forceinline__ int perm32(int rho) { const int n = rho >> 4, i = rho & 15; return 8 * (i >> 2) + 4 * n + (i & 3); }

struct Unit { int pm, pn; };
struct Gemm { const bf16_t* A; const bf16_t* Bt; int M, N, K; int lda; int gap;
    __device__ __forceinline__ const char* a_tile(int pm) const { return (const char*)(A + ((size_t)pm * BM + (size_t)(pm >> 4) * gap) * lda); } };

struct StaticOrder {
    int nM, nN, nwg, G, c;
    __host__ __device__ void init(int M, int N, int G_, int c_) { nM = M / BM; nN = N / BM; nwg = nM * nN; G = G_; c = c_; }
    __host__ __device__ bool next(int i, Unit& u) const {
        const long L = (long)i * G + c; if (L >= nwg) return false;
        int wgid = (int)L; { const int q = nwg / NXCD, r = nwg % NXCD, xcd = wgid % NXCD, off = wgid / NXCD; wgid = (xcd < r ? xcd * (q + 1) : r * (q + 1) + (xcd - r) * q) + off; }
        const int nig = WGM * nN, gid = wgid / nig, fm = gid * WGM, gsz = (nM - fm) < WGM ? (nM - fm) : WGM;
        u.pm = fm + ((wgid % nig) % gsz); u.pn = (wgid % nig) / gsz; return true;
    }
    __device__ __forceinline__ void a_ready(const Unit&) const {}
    __device__ __forceinline__ void done(const Unit&) const {}
};

__device__ __forceinline__ unsigned cvt_pk_bf16(float lo, float hi) { unsigned r; asm volatile("v_cvt_pk_bf16_f32 %0, %1, %2" : "=v"(r) : "v"(lo), "v"(hi)); return r; }
__device__ __forceinline__ float sigmoidf_(float x) { return __builtin_amdgcn_rcpf(1.f + __expf(-x)); }
__device__ __forceinline__ float tanhf_(float x) { return 1.f - 2.f * __builtin_amdgcn_rcpf(__expf(2.f * x) + 1.f); }

template <int ACT> struct EpiBf16 {
    static constexpr bool PERM = true, AFTER_DRAIN = false;
    bf16_t* O; int ldc; const float* p; int split_cols; size_t split_stride; float scale0;
    __device__ __forceinline__ float act(float v, float pv, int col) const {
        if (ACT == 1) return col < 128 ? tanhf_(v) : (col < 256 ? v : sigmoidf_(v));
        if (ACT == 2) return -0.6065306597126334f * sigmoidf_(pv + v);
        if (ACT == 3) return sigmoidf_(pv + v);
        return v;
    }
    __device__ __forceinline__ void operator()(const f32x4 (&acc)[2][2][4][2], const Unit& u, int wr, int wc, int fr, int fq) const {
        const int row0 = u.pm * BM + wr * 64 + fr; int colt = u.pn * BM; bf16_t* base = O;
        float sc = 1.f; if (split_cols) { const int t = colt / split_cols; base += (size_t)t * split_stride; colt -= t * split_cols; if (t == 0) sc = scale0; }
        const int col0 = colt + wc * 32 + 8 * fq, bcol0 = u.pn * BM + wc * 32 + 8 * fq;
#pragma unroll
        for (int bj = 0; bj < 2; ++bj) {
            const int cb = bcol0 + bj * HALF;
            f32x4 p0 = {0.f, 0.f, 0.f, 0.f}, p1 = {0.f, 0.f, 0.f, 0.f};
            if (ACT >= 2) { p0 = *(const f32x4*)(p + cb); p1 = *(const f32x4*)(p + cb + 4); }
#pragma unroll
            for (int ai = 0; ai < 2; ++ai)
#pragma unroll
                for (int m = 0; m < 4; ++m) { bf16_t* rowp = base + (size_t)(row0 + ai * HALF + m * 16) * ldc + col0 + bj * HALF;
                    f32x4 v0 = acc[ai][bj][m][0], v1 = acc[ai][bj][m][1];
                    if (ACT != 0) {
#pragma unroll
                        for (int e = 0; e < 4; ++e) { v0[e] = act(v0[e], p0[e], cb + e); v1[e] = act(v1[e], p1[e], cb + 4 + e); } }
                    v0 = v0 * sc; v1 = v1 * sc; u32x4 w; w.x = cvt_pk_bf16(v0[0], v0[1]); w.y = cvt_pk_bf16(v0[2], v0[3]); w.z = cvt_pk_bf16(v1[0], v1[1]); w.w = cvt_pk_bf16(v1[2], v1[3]);
                    *(u32x4*)rowp = w;
                    if (ACT >= 2 && (m & 1)) asm volatile("" ::: "memory"); }
        }
    }
};
struct EpiSwiglu {
    static constexpr bool PERM = true, AFTER_DRAIN = false;
    bf16_t* O; int ldc;
    __device__ __forceinline__ void operator()(const f32x4 (&acc)[2][2][4][2], const Unit& u, int wr, int wc, int fr, int fq) const {
        const int row0 = u.pm * BM + wr * 64 + fr, col0 = u.pn * HALF + wc * 32 + 8 * fq;
#pragma unroll
        for (int ai = 0; ai < 2; ++ai)
#pragma unroll
            for (int m = 0; m < 4; ++m) { bf16_t* rowp = O + (size_t)(row0 + ai * HALF + m * 16) * ldc + col0; float h[8];
#pragma unroll
                for (int n = 0; n < 2; ++n)
#pragma unroll
                    for (int e = 0; e < 4; ++e) { const float g = acc[ai][0][m][n][e], up = acc[ai][1][m][n][e]; h[4 * n + e] = g * sigmoidf_(g) * up; }
                u32x4 w; w.x = cvt_pk_bf16(h[0], h[1]); w.y = cvt_pk_bf16(h[2], h[3]); w.z = cvt_pk_bf16(h[4], h[5]); w.w = cvt_pk_bf16(h[6], h[7]);
                *(u32x4*)rowp = w; }
    }
};
struct EpiResid {
    static constexpr bool PERM = false, AFTER_DRAIN = false;
    const float* base; float* out; const float* gate; int gstride;
    __device__ __forceinline__ void operator()(const f32x4 (&acc)[2][2][4][2], const Unit& u, int wr, int wc, int fr, int fq) const {
        const int row0 = u.pm * BM + wr * 64 + fr, col0 = u.pn * BM + wc * 32 + 4 * fq; const float* gp = gate + (size_t)(u.pm >> 4) * gstride + col0;
        f32x4 gv[2][2];
#pragma unroll
        for (int bj = 0; bj < 2; ++bj)
#pragma unroll
            for (int n = 0; n < 2; ++n) gv[bj][n] = *(const f32x4*)(gp + bj * HALF + n * 16);
#pragma unroll
        for (int ai = 0; ai < 2; ++ai)
#pragma unroll
            for (int m = 0; m < 4; ++m) { const size_t off = (size_t)(row0 + ai * HALF + m * 16) * 1024 + col0;
#pragma unroll
                for (int bj = 0; bj < 2; ++bj)
#pragma unroll
                    for (int n = 0; n < 2; ++n) { const f32x4 bs = *(const f32x4*)(base + off + bj * HALF + n * 16); *(f32x4*)(out + off + bj * HALF + n * 16) = bs + gv[bj][n] * acc[ai][bj][m][n]; } }
    }
};

template <class Epi, class Sched, bool ALIGN_EPI = false, bool SP2 = false>
__device__ __forceinline__ void gemm_phase(PG8_LAS unsigned char* lds, const Gemm g, const Sched& S, const Epi& E) {
    const int tid = threadIdx.x, wid = __builtin_amdgcn_readfirstlane(tid >> 6), lane = tid & 63, wr = wid >> 2, wc = wid & 3, fr = lane & 15, fq = lane >> 4;
    const int K = g.K, nt = K / BK;
    unsigned voffA[2], voffB[2];
#pragma unroll
    for (int i = 0; i < 2; ++i) { int R, C; stage_rc(tid * 16 + i * 8192, R, C); const int Rb = Epi::PERM ? ((R & ~31) + perm32(R & 31)) : R;
        voffA[i] = (unsigned)(R * g.lda + C) * 2u; voffB[i] = (unsigned)(Rb * K + C) * 2u; }
    const size_t kstep = (size_t)(BK * 2);
    const size_t hstepA = (size_t)HALF * g.lda * 2, hstepB = (size_t)HALF * K * 2;
    const size_t tstepB = 2 * hstepB;
    const unsigned ldsw = (unsigned)wid * 1024u;
    const int aoff = lds_byte(wr * 64 + fr, fq * 8), boff = lds_byte(wc * 32 + fr, fq * 8);
#define PG8_SA(b, h) (((b) * 2 + (h)) * HTB)
#define PG8_SB(b, h) ((4 + (b) * 2 + (h)) * HTB)
#define PG8_STAGE(bufoff, gbase, voff) do { _Pragma("unroll") for (int _i = 0; _i < 2; ++_i) \
        __builtin_amdgcn_global_load_lds((const unsigned*)((const char*)(gbase) + (voff)[_i]), (PG8_LAS unsigned*)(lds + (bufoff) + ldsw + _i * 8192), 16, 0, 0); } while (0)
#define PG8_LDA(dst, b, h) do { _Pragma("unroll") for (int m = 0; m < 4; ++m) _Pragma("unroll") for (int k = 0; k < 2; ++k) dst[m][k] = *(const PG8_LAS bf16x8*)(lds + PG8_SA(b, h) + aoff + m * 2048 + k * 1024); } while (0)
#define PG8_LDB(dst, b, h) do { _Pragma("unroll") for (int n = 0; n < 2; ++n) _Pragma("unroll") for (int k = 0; k < 2; ++k) dst[n][k] = *(const PG8_LAS bf16x8*)(lds + PG8_SB(b, h) + boff + n * 2048 + k * 1024); } while (0)
#define PG8_MMA(ai, bj, At, Bt) do { __builtin_amdgcn_s_setprio(1); _Pragma("unroll") for (int m = 0; m < 4; ++m) _Pragma("unroll") for (int n = 0; n < 2; ++n) _Pragma("unroll") for (int k = 0; k < 2; ++k) \
        acc[ai][bj][m][n] = __builtin_amdgcn_mfma_f32_16x16x32_bf16(Bt[n][k], At[m][k], acc[ai][bj][m][n], 0, 0, 0); __builtin_amdgcn_s_setprio(0); } while (0)
#define PG8_WAIT_V(n) asm volatile("s_waitcnt vmcnt(" #n ")" ::: "memory")
#define PG8_WAIT_L(n) asm volatile("s_waitcnt lgkmcnt(" #n ")" ::: "memory")
#define PG8_BAR __builtin_amdgcn_s_barrier()
#define PG8_SCHED __builtin_amdgcn_sched_barrier(0)
    Unit cur, nxt; int ui = 0;
    if (!S.next(0, cur)) return;
    f32x4 acc[2][2][4][2];
#pragma unroll
    for (int a = 0; a < 2; ++a)
#pragma unroll
        for (int b = 0; b < 2; ++b)
#pragma unroll
            for (int m = 0; m < 4; ++m)
#pragma unroll
                for (int n = 0; n < 2; ++n) acc[a][b][m][n] = (f32x4){0.f, 0.f, 0.f, 0.f};
    bf16x8 At[4][2], B0[2][2], B1[2][2];
    const char* cA = g.a_tile(cur.pm); const char* cB = (const char*)g.Bt + (size_t)cur.pn * tstepB;
    S.a_ready(cur);
    if constexpr (SP2) {
        PG8_STAGE(PG8_SB(0, 0), cB, voffB); PG8_STAGE(PG8_SB(0, 1), cB + hstepB, voffB); PG8_STAGE(PG8_SA(0, 0), cA, voffA); PG8_STAGE(PG8_SA(0, 1), cA + hstepA, voffA);
        if (wr == 1) PG8_BAR;
        PG8_WAIT_V(2); PG8_BAR;
        PG8_STAGE(PG8_SB(1, 0), cB + kstep, voffB); PG8_STAGE(PG8_SA(1, 0), cA + kstep, voffA); PG8_STAGE(PG8_SB(1, 1), cB + hstepB + kstep, voffB);
        PG8_WAIT_V(6); PG8_BAR;
    } else {
        PG8_STAGE(PG8_SB(0, 0), cB, voffB); PG8_STAGE(PG8_SA(0, 0), cA, voffA); PG8_STAGE(PG8_SB(0, 1), cB + hstepB, voffB); PG8_STAGE(PG8_SA(0, 1), cA + hstepA, voffA);
        if (wr == 1) PG8_BAR;
        PG8_WAIT_V(4); PG8_BAR;
        PG8_STAGE(PG8_SB(1, 0), cB + kstep, voffB); PG8_STAGE(PG8_SA(1, 0), cA + kstep, voffA); PG8_STAGE(PG8_SB(1, 1), cB + hstepB + kstep, voffB);
        PG8_WAIT_V(6); PG8_BAR;
    }
    for (;;) {
        const bool has_next = S.next(ui + 1, nxt);
        const char* nA = has_next ? g.a_tile(nxt.pm) : cA; const char* nB = has_next ? (const char*)g.Bt + (size_t)nxt.pn * tstepB : cB;
        for (int t = 0; t < nt; t += 2) {
            const bool last = (t == nt - 2);
            const char* a1 = cA + (size_t)(t + 1) * kstep;
            const char* a2 = last ? nA : cA + (size_t)(t + 2) * kstep; const char* b2 = last ? nB : cB + (size_t)(t + 2) * kstep;
            const char* a3 = a2 + kstep; const char* b3 = b2 + kstep;
            if (last && has_next) S.a_ready(nxt);
            if constexpr (SP2) {
            PG8_LDB(B0, 0, 0); PG8_LDB(B1, 0, 1); PG8_SCHED; PG8_LDA(At, 0, 0); PG8_STAGE(PG8_SA(1, 1), a1 + hstepA, voffA);
            PG8_WAIT_V(8); PG8_WAIT_L(0); PG8_BAR; PG8_MMA(0, 0, At, B0); PG8_MMA(0, 1, At, B1); PG8_BAR; PG8_SCHED;
            PG8_LDA(At, 0, 1); PG8_STAGE(PG8_SB(0, 0), b2, voffB); PG8_STAGE(PG8_SB(0, 1), b2 + hstepB, voffB); PG8_STAGE(PG8_SA(0, 0), a2, voffA);
            PG8_WAIT_V(8); PG8_WAIT_L(0); PG8_BAR; PG8_MMA(1, 0, At, B0); PG8_MMA(1, 1, At, B1); PG8_BAR; PG8_SCHED;
            PG8_LDB(B0, 1, 0); PG8_LDB(B1, 1, 1); PG8_SCHED; PG8_LDA(At, 1, 0); PG8_STAGE(PG8_SA(0, 1), a2 + hstepA, voffA);
            PG8_WAIT_V(8); PG8_WAIT_L(0); PG8_BAR; PG8_MMA(0, 0, At, B0); PG8_MMA(0, 1, At, B1); PG8_BAR; PG8_SCHED;
            PG8_LDA(At, 1, 1); PG8_STAGE(PG8_SB(1, 0), b3, voffB); PG8_STAGE(PG8_SB(1, 1), b3 + hstepB, voffB); PG8_STAGE(PG8_SA(1, 0), a3, voffA);
            PG8_WAIT_V(8); PG8_WAIT_L(0); PG8_BAR; PG8_MMA(1, 0, At, B0); PG8_MMA(1, 1, At, B1); PG8_BAR; PG8_SCHED;
            } else {
            PG8_LDB(B0, 0, 0); PG8_SCHED; PG8_LDA(At, 0, 0); PG8_STAGE(PG8_SA(1, 1), a1 + hstepA, voffA);
            PG8_WAIT_L(8); PG8_BAR; PG8_WAIT_L(0); PG8_MMA(0, 0, At, B0); PG8_BAR; PG8_SCHED;
            PG8_LDB(B1, 0, 1); PG8_STAGE(PG8_SB(0, 0), b2, voffB);
            PG8_BAR; PG8_WAIT_L(0); PG8_MMA(0, 1, At, B1); PG8_BAR;
            PG8_LDA(At, 0, 1); PG8_STAGE(PG8_SA(0, 0), a2, voffA);
            PG8_BAR; PG8_WAIT_L(0); PG8_MMA(1, 0, At, B0); PG8_BAR; PG8_SCHED;
            PG8_STAGE(PG8_SB(0, 1), b2 + hstepB, voffB);
            PG8_WAIT_V(6); PG8_BAR; PG8_MMA(1, 1, At, B1); PG8_BAR;
            PG8_LDB(B0, 1, 0); PG8_SCHED; PG8_LDA(At, 1, 0); PG8_STAGE(PG8_SA(0, 1), a2 + hstepA, voffA);
            PG8_WAIT_L(8); PG8_BAR; PG8_WAIT_L(0); PG8_MMA(0, 0, At, B0); PG8_BAR; PG8_SCHED;
            PG8_LDB(B1, 1, 1); PG8_STAGE(PG8_SB(1, 0), b3, voffB);
            PG8_BAR; PG8_WAIT_L(0); PG8_MMA(0, 1, At, B1); PG8_BAR;
            PG8_LDA(At, 1, 1); PG8_STAGE(PG8_SA(1, 0), a3, voffA);
            PG8_BAR; PG8_WAIT_L(0); PG8_MMA(1, 0, At, B0); PG8_BAR; PG8_SCHED;
            PG8_STAGE(PG8_SB(1, 1), b3 + hstepB, voffB);
            PG8_WAIT_V(6); PG8_BAR; PG8_MMA(1, 1, At, B1); PG8_BAR;
            }
        }
        if constexpr (ALIGN_EPI) { if (wr == 0) PG8_BAR; }
        if constexpr (!Epi::AFTER_DRAIN) { E(acc, cur, wr, wc, fr, fq); S.done(cur); }
        if (!has_next) break;
#pragma unroll
        for (int a = 0; a < 2; ++a)
#pragma unroll
            for (int b = 0; b < 2; ++b)
#pragma unroll
                for (int m = 0; m < 4; ++m)
#pragma unroll
                    for (int n = 0; n < 2; ++n) acc[a][b][m][n] = (f32x4){0.f, 0.f, 0.f, 0.f};
        cur = nxt; cA = nA; cB = nB; ++ui;
        if constexpr (ALIGN_EPI) { if (wr == 1) PG8_BAR; }
    }
    PG8_WAIT_V(0);
    if constexpr (!ALIGN_EPI) { if (wr == 0) PG8_BAR; }
    PG8_BAR;
    if constexpr (Epi::AFTER_DRAIN) { E.fused(acc, cur, wr, wc, fr, fq, lds, wid, lane); S.done(cur); }
#undef PG8_SA
#undef PG8_SB
#undef PG8_STAGE
#undef PG8_LDA
#undef PG8_LDB
#undef PG8_MMA
#undef PG8_WAIT_V
#undef PG8_WAIT_L
#undef PG8_BAR
#undef PG8_SCHED
}
}

constexpr int NWAVES = 8, NTHR = 512;
constexpr int BATCH = 4, SEQ = 4096, D = 1024, M = BATCH * SEQ, HD = 64, NH = 16, NFOX = 8, NMOBA = 8;
constexpr int IN_COLS = 3080, DFF = 2816, MOD6 = 6 * D;
constexpr int MOBA_BLK = 256, MOBA_NB = SEQ / MOBA_BLK;
constexpr float NORM_EPS = 1e-6f, GN_EPS = 64e-5f;
constexpr float C2 = 0.125f * 1.4426950408889634f;
constexpr float LOG2E = 1.4426950408889634f;

constexpr size_t MiB = 1u << 20;
constexpr size_t WS_CTL = 0, CTL_ZERO_BYTES = 1 * MiB;
constexpr size_t WS_MOD = 1 * MiB;
constexpr size_t WS_LSIG = WS_MOD + 256 * 1024;
constexpr size_t WS_CUM = WS_LSIG + 512 * 1024;
constexpr size_t WS_KMEAN = WS_CUM + 512 * 1024;
constexpr size_t WS_BONUS = WS_LSIG;
constexpr size_t WS_WO = 3 * MiB;
constexpr size_t WS_WF1IN = 5 * MiB;
constexpr size_t WS_WF1OUT = 16 * MiB;
constexpr size_t WS_WR = 22 * MiB, WS_WK = 24 * MiB, WS_WV = 26 * MiB;
constexpr size_t WS_WLD = 28 * MiB;
constexpr size_t WS_WW2 = 30 * MiB, WS_WA2 = WS_WW2 + 256 * 1024, WS_WG2 = WS_WW2 + 512 * 1024;
constexpr size_t WS_WQKV = 31 * MiB;
constexpr size_t WS_WOUT = 37 * MiB;
constexpr size_t WS_WF0IN = 39 * MiB;
constexpr size_t WS_WF0OUT = 50 * MiB;
constexpr size_t WS_XK = 56 * MiB, WS_XQ = 58 * MiB;
constexpr size_t SLOT = 32 * MiB;
constexpr size_t WS_AM1 = 32 * MiB;
constexpr size_t WS_A0 = 64 * MiB, WS_A1 = 96 * MiB, WS_A2 = 128 * MiB, WS_A3 = 160 * MiB, WS_A4 = 192 * MiB, WS_A5 = 224 * MiB, WS_END = 256 * MiB;
constexpr size_t WS_XN1G = WS_A0 - 8192;
static_assert(WS_WF0OUT + (size_t)D * DFF * 2 <= WS_A0 && WS_WG2 + 512 * 1024 <= WS_WQKV && WS_WF1OUT + (size_t)D * DFF * 2 <= WS_WR, "d_ws map");

constexpr int CW_BAR = 4096;

constexpr int RING_OFF = 0, RING_BYTES = 131072;
constexpr int LDSCTL_OFF = RING_BYTES, MISC_OFF = LDSCTL_OFF + 320;
constexpr int LDS_BYTES = 147456;
static_assert(MISC_OFF + 128 <= LDS_BYTES, "LDS map");

#define GAS __attribute__((address_space(1)))
#define LAS __attribute__((address_space(3)))
typedef unsigned short bf16;
typedef unsigned v4u __attribute__((ext_vector_type(4)));
typedef float f32x4 __attribute__((ext_vector_type(4)));
typedef short bf16x8 __attribute__((ext_vector_type(8)));
typedef GAS unsigned gu32;
typedef GAS unsigned long long gu64;
#define RLX_AGENT __ATOMIC_RELAXED, __HIP_MEMORY_SCOPE_AGENT
#define LDS_WAIT() asm volatile("s_waitcnt lgkmcnt(0)" ::: "memory")
#define VM_WAIT() asm volatile("s_waitcnt vmcnt(0)" ::: "memory")
__device__ __forceinline__ unsigned long long rt() { return __builtin_amdgcn_s_memrealtime(); }
__device__ __forceinline__ unsigned f2bf(float f) { unsigned u = __builtin_bit_cast(unsigned, f); return (u + 0x7fffu + ((u >> 16) & 1u)) >> 16; }
__device__ __forceinline__ unsigned pk2(float lo, float hi) { return f2bf(lo) | (f2bf(hi) << 16); }

#define XB_TMO      128
#define XB_XCNT(j)  (256  + 64 * (j))
#define XB_XSUB(j)  (1280 + 64 * (j))
#define XB_XGEN(j)  (2304 + 64 * (j))
#define XB_TOP      3328
#define XB_TOPGEN   3392
#define XCD_BAR_WORDS 3456
#define XB_SPIN_CAP (1u << 18)

__device__ __forceinline__ unsigned xb_ld(unsigned* p)              { return __hip_atomic_load(p, __ATOMIC_RELAXED, __HIP_MEMORY_SCOPE_AGENT); }
__device__ __forceinline__ unsigned xb_add(unsigned* p, unsigned v) { return __hip_atomic_fetch_add(p, v, __ATOMIC_RELAXED, __HIP_MEMORY_SCOPE_AGENT); }
__device__ __forceinline__ unsigned xb_xcc_id() { return (unsigned)__builtin_amdgcn_s_getreg((3 << 11) | 20) & 0xFu; }
#define XB_SPIN(cond, bar) do { unsigned _sp = 0; while (cond) { __builtin_amdgcn_s_sleep(1); \
    if ((++_sp & 255u) == 0u) { if (xb_ld(&(bar)[XB_TMO])) break; if (_sp > XB_SPIN_CAP) { atomicAdd(&(bar)[XB_TMO], 1u); break; } } } } while (0)

struct XcdBarrier {
    unsigned* bar; unsigned x;
    volatile LAS unsigned* st;
};

__device__ __forceinline__ XcdBarrier xcd_barrier_post(unsigned* bar, volatile LAS unsigned* st) {
    XcdBarrier b; b.bar = bar; b.x = xb_xcc_id(); b.st = st;
    if (threadIdx.x == 0) (void)xb_add(&bar[XB_XCNT(b.x)], 1u);
    return b;
}
__device__ __forceinline__ void xcd_barrier_complete(unsigned* bar, unsigned x, unsigned& nloc, unsigned& nx) {
    const unsigned G = gridDim.x * gridDim.y * gridDim.z;
    unsigned sum, cnt, mine, sp = 0u;
    for (;;) {
        sum = 0u; cnt = 0u; mine = 0u;
#pragma unroll
        for (unsigned j = 0; j < 16; ++j) { const unsigned c = xb_ld(&bar[XB_XCNT(j)]); sum += c; cnt += (c > 0u) ? 1u : 0u; mine = (j == x) ? c : mine; }
        if (sum == G) break;
        __builtin_amdgcn_s_sleep(1);
        if ((++sp & 255u) == 0u) { if (xb_ld(&bar[XB_TMO])) break; if (sp > XB_SPIN_CAP) { atomicAdd(&bar[XB_TMO], 1u); break; } }
    }
    nloc = mine > 0u ? mine : 1u; nx = cnt > 0u ? cnt : 1u;
}

__device__ __forceinline__ void xcd_barrier(const XcdBarrier& b) {
    asm volatile("s_waitcnt vmcnt(0)" ::: "memory");
    __syncthreads();
    if (threadIdx.x == 0) {
        unsigned* bar = b.bar;
        __builtin_amdgcn_s_waitcnt(0);
        unsigned nloc = b.st[0], nx = b.st[1];
        if (nloc == 0u) { xcd_barrier_complete(bar, b.x, nloc, nx); b.st[0] = nloc; b.st[1] = nx; }
        const unsigned old = xb_add(&bar[XB_XSUB(b.x)], 1u);
        const unsigned gen = old / nloc;
        if (old + 1u == (gen + 1u) * nloc) {
            __builtin_amdgcn_fence(__ATOMIC_RELEASE, "agent");
            asm volatile("s_waitcnt vmcnt(0)" ::: "memory");
            const unsigned og = xb_add(&bar[XB_TOP], 1u);
            const unsigned tg = og / nx;
            if (og + 1u == (tg + 1u) * nx) xb_add(&bar[XB_TOPGEN], 1u);
            else XB_SPIN(xb_ld(&bar[XB_TOPGEN]) == tg, bar);
            __builtin_amdgcn_fence(__ATOMIC_ACQUIRE, "agent");
            xb_add(&bar[XB_XGEN(b.x)], 1u);
            asm volatile("s_waitcnt vmcnt(0)" ::: "memory");
        } else {
            XB_SPIN(xb_ld(&bar[XB_XGEN(b.x)]) == gen, bar);
            __builtin_amdgcn_fence(__ATOMIC_ACQUIRE, "agent");
            asm volatile("s_waitcnt vmcnt(0)" ::: "memory");
        }
    }
    __syncthreads();
}

#include <hip/hip_bf16.h>
#include <cmath>
namespace attn_body {
using bf16=__hip_bfloat16;
using bf16x8=__attribute__((ext_vector_type(8)))short;
using s16x4=__attribute__((ext_vector_type(4)))short;
using f32x16=__attribute__((ext_vector_type(16)))float;
using u32x4=__attribute__((ext_vector_type(4)))unsigned;
constexpr int BATCH=4,NHEAD=16,SEQ=4096,D=64,DM=NHEAD*D;
constexpr int NW=8,QBLK=32,QB=QBLK*NW,KVBLK=64,NQB=SEQ/QB;
__device__ __forceinline__ int crow(int r,int hi){return (r&3)+8*(r>>2)+4*hi;}
#define SBAR() __builtin_amdgcn_sched_barrier(0)
__device__ __forceinline__ void cmask(f32x16&p0,f32x16&p1,int jb,int qrel,int hi){
  const float NEG=-INFINITY; int kb=64*jb+4*hi;
  #pragma unroll
  for(int r=0;r<16;++r){int kv=kb+(r&3)+8*(r>>2); if(kv>qrel)p0[r]=NEG; if(kv+32>qrel)p1[r]=NEG;}
}

constexpr int NSLOT=3, SLOTB=9216;
constexpr int LDS_K=0, LDS_V=NSLOT*SLOTB, LDS_WS=2*NSLOT*SLOTB, LDS_OST=LDS_WS+NW*64*4, LDS_BYTES=LDS_OST+NW*4096;
__device__ __forceinline__ void glds16(const void*gsrc,unsigned lds_dst){unsigned keep;
  asm volatile("s_mov_b32 %0, m0\n\ts_mov_b32 m0, %2\n\ts_nop 0\n\tglobal_load_lds_dwordx4 %1, off\n\ts_mov_b32 m0, %0":"=&s"(keep):"v"(gsrc),"s"(lds_dst):"memory");}
__device__ __forceinline__ float max3f(float a,float b,float c){float r;asm("v_max3_f32 %0, %1, %2, %3":"=v"(r):"v"(a),"v"(b),"v"(c));return r;}
__device__ __forceinline__ float max2f(float a,float b){float r;asm("v_max_f32_e32 %0, %1, %2":"=v"(r):"v"(a),"v"(b));return r;}
__device__ __forceinline__ float fadd_s(float a,float b){float r;asm("v_add_f32_e32 %0, %1, %2":"=v"(r):"v"(a),"v"(b));return r;}
__device__ __forceinline__ float fsub_s(float a,float b){float r;asm("v_sub_f32_e32 %0, %1, %2":"=v"(r):"v"(a),"v"(b));return r;}
typedef float f32x2_t __attribute__((ext_vector_type(2))); typedef __bf16 bf16x2_t __attribute__((ext_vector_type(2)));
__device__ __forceinline__ unsigned cvtpk_s(float lo,float hi){f32x2_t v={lo,hi};bf16x2_t b=__builtin_convertvector(v,bf16x2_t);return __builtin_bit_cast(unsigned,b);}
#define WAIT_BAR(N) asm volatile("s_waitcnt vmcnt(" #N ") lgkmcnt(0)\n\ts_barrier":::"memory")

template<bool FOX> __device__ __forceinline__ void qkt(f32x16&p0,f32x16&p1,const char*Kslot,const bf16x8*qr,const f32x16&negm,int r32,int hi){
  const char*kb=Kslot+hi*1024+r32*16;
  #pragma unroll
  for(int d0=0;d0<4;++d0){
    const bf16x8 b0=*reinterpret_cast<const bf16x8*>(kb+d0*2048);
    const bf16x8 b1=*reinterpret_cast<const bf16x8*>(kb+d0*2048+512);
    if(d0==0){p0=__builtin_amdgcn_mfma_f32_32x32x16_bf16(b0,qr[0],negm,0,0,0);p1=__builtin_amdgcn_mfma_f32_32x32x16_bf16(b1,qr[0],negm,0,0,0);}
    else{p0=__builtin_amdgcn_mfma_f32_32x32x16_bf16(b0,qr[d0],p0,0,0,0);p1=__builtin_amdgcn_mfma_f32_32x32x16_bf16(b1,qr[d0],p1,0,0,0);}}
  if(FOX){ const char*kx=Kslot+8192+r32*16;
    const bf16x8 b0=*reinterpret_cast<const bf16x8*>(kx); const bf16x8 b1=*reinterpret_cast<const bf16x8*>(kx+512);
    p0=__builtin_amdgcn_mfma_f32_32x32x16_bf16(b0,qr[4],p0,0,0,0);p1=__builtin_amdgcn_mfma_f32_32x32x16_bf16(b1,qr[4],p1,0,0,0);}
}
typedef __attribute__((address_space(3))) const char* lds_cptr;
typedef short v4i16_t __attribute__((ext_vector_type(4)));
#define LDSV8(p) (*(const __attribute__((address_space(3))) bf16x8*)(p))
template<bool FOX> __device__ __forceinline__ void kload_all(bf16x8*kf,lds_cptr kp,lds_cptr kx){
  kf[0]=LDSV8(kp);      kf[1]=LDSV8(kp+512);
  kf[2]=LDSV8(kp+2048); kf[3]=LDSV8(kp+2560);
  kf[4]=LDSV8(kp+4096); kf[5]=LDSV8(kp+4608);
  kf[6]=LDSV8(kp+6144); kf[7]=LDSV8(kp+6656);
  if(FOX){ kf[8]=LDSV8(kx); kf[9]=LDSV8(kx+512); }
}
__device__ __forceinline__ void kload2(bf16x8*kf,lds_cptr kp,int j){ kf[2*j]=LDSV8(kp+j*2048); kf[2*j+1]=LDSV8(kp+j*2048+512); }
__device__ __forceinline__ s16x4 vtr(lds_cptr p){ return __builtin_bit_cast(s16x4,__builtin_amdgcn_ds_read_tr16_b64_v4i16((__attribute__((address_space(3))) v4i16_t*)p)); }
__device__ __forceinline__ float rowmax(const f32x16&p0,const f32x16&p1){
  float a=max3f(p0[0],p0[1],p1[0]),b=max3f(p0[2],p0[3],p1[1]);a=max3f(a,p1[2],p1[3]);
  #pragma unroll
  for(int r=4;r<16;r+=4){a=max3f(a,p0[r],p0[r+1]);b=max3f(b,p0[r+2],p0[r+3]);a=max3f(a,p1[r],p1[r+1]);b=max3f(b,p1[r+2],p1[r+3]);}
  const float m=max2f(a,b);
  auto rr=__builtin_amdgcn_permlane32_swap(__float_as_uint(m),__float_as_uint(m),false,false);
  return max2f(__uint_as_float(rr[0]),__uint_as_float(rr[1]));
}
__device__ __forceinline__ void pv(f32x16*o,int vb,bf16x8 pa0,bf16x8 pa1,bf16x8 pa2,bf16x8 pa3){
  #pragma unroll
  for(int d0=0;d0<2;++d0){s16x4 lo[4],hi[4];
    #pragma unroll
    for(int ks=0;ks<4;++ks){
      asm volatile("ds_read_b64_tr_b16 %0,%1 offset:%c2":"=&v"(lo[ks]):"v"(vb),"i"(d0*4096+ks*1024):"memory");
      asm volatile("ds_read_b64_tr_b16 %0,%1 offset:%c2":"=&v"(hi[ks]):"v"(vb),"i"(d0*4096+ks*1024+512):"memory");}
    asm volatile("s_waitcnt lgkmcnt(0)":::"memory");SBAR();
    #define PK(k) (bf16x8){lo[k][0],lo[k][1],lo[k][2],lo[k][3],hi[k][0],hi[k][1],hi[k][2],hi[k][3]}
    o[d0]=__builtin_amdgcn_mfma_f32_32x32x16_bf16(pa0,PK(0),o[d0],0,0,0);
    o[d0]=__builtin_amdgcn_mfma_f32_32x32x16_bf16(pa1,PK(1),o[d0],0,0,0);
    o[d0]=__builtin_amdgcn_mfma_f32_32x32x16_bf16(pa2,PK(2),o[d0],0,0,0);
    o[d0]=__builtin_amdgcn_mfma_f32_32x32x16_bf16(pa3,PK(3),o[d0],0,0,0);
    #undef PK
  }
}

#ifndef ATTN_STORE16
#define ATTN_STORE16(p,v) (*(u32x4*)(p)=(v))
#endif
template<int THRL,bool FOX> __device__ __forceinline__ void attn_unit(int b,int h,int qb,const bf16*Q,const bf16*__restrict__ K,const bf16*__restrict__ V,bf16*O,char*shm,
                                                                      const bf16*__restrict__ XK,const bf16*__restrict__ XQ,const float*__restrict__ kmean){
  int tid_=threadIdx.x; asm volatile("":"+v"(tid_));
  const int tid=tid_,lane=tid&63,r32=lane&31,hi=lane>>5; const int wid=__builtin_amdgcn_readfirstlane(tid>>6);
  const long rowbase=(long)b*SEQ; const int q0=qb*QB;
  const bf16*Qw=Q+(rowbase+q0+wid*QBLK)*DM+h*D;
  const bf16*Kh=K+rowbase*DM+h*D,*Vh=V+rowbase*DM+h*D;
  const unsigned lds0=(unsigned)(uintptr_t)shm;
  float*wsf=(float*)(shm+LDS_WS)+wid*64;
  const bf16*ksrc=Kh+(long)lane*DM+wid*8;
  const bf16*vsrc=Vh+(long)(16*(wid&3)+(lane>>2))*DM+(wid>>2)*32+(lane&3)*8;
  const bf16*xsrc=FOX?XK+((long)(b*8+h)*SEQ+lane)*8:nullptr;
  const unsigned kdst=lds0+LDS_K+wid*1024, vdst=lds0+LDS_V+wid*1024, xdst=lds0+LDS_K+8192;
  #define PT(t) (FOX?(t):(((t)<4)?(4*qb+(t)):((t)-4)))
  #define DMA_K(t,slot) do{ glds16(ksrc+(long)PT(t)*KVBLK*DM,(unsigned)__builtin_amdgcn_readfirstlane(kdst+(slot))); \
                            if(FOX&&wid==0) glds16(xsrc+(long)PT(t)*KVBLK*8,(unsigned)__builtin_amdgcn_readfirstlane(xdst+(slot))); }while(0)
  #define DMA_V(t,slot) glds16(vsrc+(long)PT(t)*KVBLK*DM,(unsigned)__builtin_amdgcn_readfirstlane(vdst+(slot)))
  #define WAITX(N,HASK) do{ if(FOX&&(HASK)&&wid==0){ if((N)==2)WAIT_BAR(3); else if((N)==1)WAIT_BAR(2); else WAIT_BAR(1);} else { if((N)==2)WAIT_BAR(2); else if((N)==1)WAIT_BAR(1); else WAIT_BAR(0);} }while(0)
  const int vb0=(int)(lds0+LDS_V)+((lane>>4)&1)*32+(lane&3)*8+(4*hi+((lane&15)>>2))*64;
  const char*Kbase=shm+LDS_K; bf16x8 kf[FOX?10:8];
  const lds_cptr shm3=(lds_cptr)shm; const lds_cptr kp0=shm3+LDS_K+hi*1024+r32*16; const lds_cptr kx0=shm3+LDS_K+8192+r32*16; const lds_cptr vp0=shm3+LDS_V+((lane>>4)&1)*32+(lane&3)*8+(4*hi+((lane&15)>>2))*64;
  const int NT=(q0+QB)/KVBLK;
  DMA_K(0,0);DMA_V(0,0);DMA_K(1,SLOTB);
  bf16x8 qr[FOX?5:4];
  #pragma unroll
  for(int d0=0;d0<4;++d0)qr[d0]=*reinterpret_cast<const bf16x8*>(&Qw[(long)r32*DM+d0*16+hi*8]);
  if(FOX){ bf16x8 xq=*reinterpret_cast<const bf16x8*>(XQ+((long)(b*8+h)*SEQ+q0+wid*QBLK+r32)*8); if(hi)xq=(bf16x8){0,0,0,0,0,0,0,0}; qr[FOX?4:0]=xq; }
  unsigned msk=0u;
  if(!FOX){
    float qf[32];
    #pragma unroll
    for(int d0=0;d0<4;++d0)
      #pragma unroll
      for(int j=0;j<8;++j)qf[8*d0+j]=__uint_as_float(((unsigned)(unsigned short)qr[d0][j])<<16);
    float g[16];
    const float*km0=kmean+((long)(b*8+(h-8))*16)*64+8*hi;
    #pragma unroll
    for(int n=0;n<16;++n){ g[n]=-INFINITY;
      if(n<qb){ const float*km=km0+n*64; float s=0.f;
        #pragma unroll
        for(int d0=0;d0<4;++d0){ const float4 k0=*reinterpret_cast<const float4*>(km+16*d0), k1=*reinterpret_cast<const float4*>(km+16*d0+4);
          s+=qf[8*d0]*k0.x+qf[8*d0+1]*k0.y+qf[8*d0+2]*k0.z+qf[8*d0+3]*k0.w+qf[8*d0+4]*k1.x+qf[8*d0+5]*k1.y+qf[8*d0+6]*k1.z+qf[8*d0+7]*k1.w; }
        auto rr=__builtin_amdgcn_permlane32_swap(__float_as_uint(s),__float_as_uint(s),false,false);
        g[n]=__uint_as_float(rr[0])+__uint_as_float(rr[1]); } }
    #pragma unroll
    for(int n=0;n<16;++n){ int rank=0;
      #pragma unroll
      for(int m=0;m<16;++m) rank+=(g[m]>g[n]||(g[m]==g[n]&&m<n))?1:0;
      if(n<qb&&rank<3)msk|=(1u<<n); }
  }
  float mhat=0.f,l_reg=0.f,selb=0.f;f32x16 o[2];o[0]=f32x16{};o[1]=f32x16{};f32x16 negm;{float z_;asm volatile("v_mov_b32 %0, 0":"=v"(z_));
  #pragma unroll
  for(int r=0;r<16;++r)negm[r]=z_;}
  if(!FOX)asm volatile("":"+v"(negm));const f32x16 z16=f32x16{};
  const int qrel=wid*QBLK+r32;
  #define CMASK(P0,P1,t) do{ if(FOX){int jb_=(t)-(NT-4); if(jb_>=0)cmask(P0,P1,jb_,qrel,hi);} else { if((t)<4)cmask(P0,P1,(t),qrel,hi);} }while(0)
  #define BLKSEL(t) do{ if(!FOX&&(t)>=4&&(((t)&3)==0)){ selb=((msk>>(((t)-4)>>2))&1u)?0.f:-INFINITY; const float x_=selb-mhat; \
      _Pragma("unroll") for(int r=0;r<16;++r)negm[r]=x_; asm volatile("":"+v"(negm)); } }while(0)
  bool resc=false;
  #define SETREF() do{ if(FOX){ const float nm_=-mhat; const unsigned n1_=cvtpk_s(nm_,0.f)&0xffffu; const unsigned n2_=cvtpk_s(nm_-__uint_as_float(n1_<<16),0.f)&0xffffu; \
        if(hi==0){ qr[FOX?4:0][6]=(short)n1_; qr[FOX?4:0][7]=(short)n2_; } } \
      else { const float x_=selb-mhat; _Pragma("unroll") for(int r=0;r<16;++r)negm[r]=x_; asm volatile("":"+v"(negm)); } }while(0)
  #define START(P0,P1) do{ const float rm=rowmax(P0,P1); resc=false; \
    { const float dl=FOX?__builtin_ceilf(rm):rm; mhat=fadd_s(mhat,dl); \
      _Pragma("unroll") for(int r=0;r<16;++r){P0[r]=fsub_s(P0[r],dl);P1[r]=fsub_s(P1[r],dl);} \
      SETREF(); } \
    _Pragma("unroll") for(int r=0;r<16;++r)P0[r]=__builtin_amdgcn_exp2f(P0[r]); }while(0)
  #define RESC() do{ if(resc){ asm volatile("s_waitcnt lgkmcnt(0)":::"memory"); \
      _Pragma("unroll") for(int d_=0;d_<2;++d_) _Pragma("unroll") for(int r=0;r<16;++r)o[d_][r]*=wsf[crow(r,hi)]; } }while(0)
  f32x16 pA0,pA1,pB0,pB1;
  int sl_prev=0,sl_cur=0,sl_next=SLOTB;
  #define ROT() do{sl_prev=sl_cur;sl_cur=sl_next;sl_next=(sl_next==(NSLOT-1)*SLOTB)?0:sl_next+SLOTB;}while(0)
  DMA_K(2,2*SLOTB);
  WAIT_BAR(3);
  qkt<FOX>(pA0,pA1,Kbase,qr,(FOX?z16:negm),r32,hi);asm volatile("s_nop 15\n\ts_nop 7":"+v"(pA0),"+v"(pA1));CMASK(pA0,pA1,0);
  START(pA0,pA1);
  _Pragma("unroll") for(int r=0;r<16;++r)pA1[r]=__builtin_amdgcn_exp2f(pA1[r]);
  WAIT_BAR(0);
  DMA_K(3,0);DMA_V(1,SLOTB);
  ROT();
  kload_all<FOX>(kf,kp0+sl_cur,kx0+sl_cur);
  WAITX(2,true);
  s16x4 vlo[8],vhi[8]; u32x4 pw0,pw1,pw2,pw3;
  #define PKW(P,B) cvtpk_s(P[B],P[B+1])
  #define PAF(k) __builtin_bit_cast(bf16x8,pw##k)
  #define VFR(i) (bf16x8){vlo[i][0],vlo[i][1],vlo[i][2],vlo[i][3],vhi[i][0],vhi[i][1],vhi[i][2],vhi[i][3]}
  #define PIN(x) asm volatile("":"+v"(x))
  #define MX3(a,b,c) __builtin_fmaxf(__builtin_fmaxf((a),(b)),(c))
  #define GAPA(MF,A0,A1,A2,A3,W0,W1,PW) do{ MF; sacc+=A0; sacc+=A1; sacc+=A2; sacc+=A3; PIN(sacc); W0; W1; PIN(PW); SBAR(); }while(0)
  #define EX(v) __builtin_amdgcn_exp2f(v)
  #define GAPB(MF,X,B) do{ MF; X[B]=EX(X[B]); X[B+1]=EX(X[B+1]); X[B+2]=EX(X[B+2]); X[B+3]=EX(X[B+3]); PIN(X); SBAR(); }while(0)
  #define VRD(i) do{ vlo[i]=vtr(vp_+(((i)>>2)*4096+((i)&3)*1024)); vhi[i]=vtr(vp_+(((i)>>2)*4096+((i)&3)*1024+512)); }while(0)
  #define KRD(G,j) do{ if(G){ kload2(kf,kp0+sl_next,j); SBAR(); } }while(0)
  #define KRDX(G) do{ if(FOX&&(G)){ kf[FOX?8:0]=LDSV8(kx0+sl_next); kf[FOX?9:1]=LDSV8(kx0+sl_next+512); SBAR(); } }while(0)
  #define XMF(C0,C1) do{ if(FOX){ C0=__builtin_amdgcn_mfma_f32_32x32x16_bf16(kf[FOX?8:0],qr[FOX?4:0],C0,0,0,0); C1=__builtin_amdgcn_mfma_f32_32x32x16_bf16(kf[FOX?9:1],qr[FOX?4:0],C1,0,0,0); SBAR(); } }while(0)
  #define STEP(C0,C1,P0,P1,t,GK,GV,GL) do{ SBAR(); BLKSEL(t); \
    const lds_cptr vp_=vp0+sl_prev; \
    VRD(0); SBAR(); float sacc=(P0[0]+P0[1]); \
    GAPA(C0=__builtin_amdgcn_mfma_f32_32x32x16_bf16(kf[0],qr[0],(FOX?z16:negm),0,0,0), P0[2],P0[3],P0[4],P0[5],     pw0[0]=PKW(P0,0), pw0[1]=PKW(P0,2), pw0); \
    VRD(4); SBAR(); GAPA(C1=__builtin_amdgcn_mfma_f32_32x32x16_bf16(kf[1],qr[0],(FOX?z16:negm),0,0,0), P0[6],P0[7],P0[8],P0[9],     pw0[2]=PKW(P0,4), pw0[3]=PKW(P0,6), pw0); \
    VRD(1); SBAR(); GAPA(C0=__builtin_amdgcn_mfma_f32_32x32x16_bf16(kf[2],qr[1],C0,0,0,0),   P0[10],P0[11],P0[12],P0[13], pw1[0]=PKW(P0,8), pw1[1]=PKW(P0,10), pw1); \
    VRD(5); SBAR(); GAPA(C1=__builtin_amdgcn_mfma_f32_32x32x16_bf16(kf[3],qr[1],C1,0,0,0),   P0[14],P0[15],P1[0],P1[1],   pw1[2]=PKW(P0,12),pw1[3]=PKW(P0,14), pw1); \
    VRD(2); SBAR(); GAPA(C0=__builtin_amdgcn_mfma_f32_32x32x16_bf16(kf[4],qr[2],C0,0,0,0),   P1[2],P1[3],P1[4],P1[5],     pw2[0]=PKW(P1,0), pw2[1]=PKW(P1,2), pw2); \
    VRD(6); SBAR(); GAPA(C1=__builtin_amdgcn_mfma_f32_32x32x16_bf16(kf[5],qr[2],C1,0,0,0),   P1[6],P1[7],P1[8],P1[9],     pw2[2]=PKW(P1,4), pw2[3]=PKW(P1,6), pw2); \
    VRD(3); SBAR(); GAPA(C0=__builtin_amdgcn_mfma_f32_32x32x16_bf16(kf[6],qr[3],C0,0,0,0),   P1[10],P1[11],P1[12],P1[13], pw3[0]=PKW(P1,8), pw3[1]=PKW(P1,10), pw3); \
    VRD(7); SBAR(); GAPA(C1=__builtin_amdgcn_mfma_f32_32x32x16_bf16(kf[7],qr[3],C1,0,0,0),   P1[14],P1[15],0.f,0.f,       pw3[2]=PKW(P1,12),pw3[3]=PKW(P1,14), pw3); \
    XMF(C0,C1); \
    l_reg+=sacc; \
    if(GK){DMA_K((t)+3,sl_cur);} if(GV){DMA_V((t)+1,sl_next);} \
    CMASK(C0,C1,t); \
    { float a=MX3(C0[0],C0[1],C1[0]),b=MX3(C0[2],C0[3],C1[1]); a=MX3(a,C1[2],C1[3]); \
      _Pragma("unroll") for(int r=4;r<16;r+=4){a=MX3(a,C0[r],C0[r+1]);b=MX3(b,C0[r+2],C0[r+3]);a=MX3(a,C1[r],C1[r+1]);b=MX3(b,C1[r+2],C1[r+3]);} \
      float rm=__builtin_fmaxf(a,b); { auto rr=__builtin_amdgcn_permlane32_swap(__float_as_uint(rm),__float_as_uint(rm),false,false); rm=__builtin_fmaxf(__uint_as_float(rr[0]),__uint_as_float(rr[1])); } \
      resc=false; \
      if(__builtin_expect(__any(rm>(float)THRL),0)){ const float dl=FOX?__builtin_ceilf(__builtin_fmaxf(rm,0.f)):__builtin_fmaxf(rm,0.f); mhat+=dl; \
        _Pragma("unroll") for(int r=0;r<16;++r){C0[r]-=dl;C1[r]-=dl;} \
        SETREF(); \
        const float f=__builtin_amdgcn_exp2f(-dl); l_reg*=f; if(hi==0)wsf[r32]=f; resc=true; } } \
    SBAR(); \
    GAPB(o[0]=__builtin_amdgcn_mfma_f32_32x32x16_bf16(PAF(0),VFR(0),o[0],0,0,0), C0,0); \
    GAPB(o[1]=__builtin_amdgcn_mfma_f32_32x32x16_bf16(PAF(0),VFR(4),o[1],0,0,0), C0,4); \
    KRD(GL,0); GAPB(o[0]=__builtin_amdgcn_mfma_f32_32x32x16_bf16(PAF(1),VFR(1),o[0],0,0,0), C0,8); \
    KRD(GL,1); GAPB(o[1]=__builtin_amdgcn_mfma_f32_32x32x16_bf16(PAF(1),VFR(5),o[1],0,0,0), C0,12); \
    KRD(GL,2); GAPB(o[0]=__builtin_amdgcn_mfma_f32_32x32x16_bf16(PAF(2),VFR(2),o[0],0,0,0), C1,0); \
    KRD(GL,3); GAPB(o[1]=__builtin_amdgcn_mfma_f32_32x32x16_bf16(PAF(2),VFR(6),o[1],0,0,0), C1,4); \
    KRDX(GL); GAPB(o[0]=__builtin_amdgcn_mfma_f32_32x32x16_bf16(PAF(3),VFR(3),o[0],0,0,0), C1,8); \
    GAPB(o[1]=__builtin_amdgcn_mfma_f32_32x32x16_bf16(PAF(3),VFR(7),o[1],0,0,0), C1,12); \
    }while(0)
  int t=1;
  for(;t+5<NT;t+=2){
    STEP(pB0,pB1,pA0,pA1,t,true,true,true);     WAITX(2,true); RESC(); ROT();
    STEP(pA0,pA1,pB0,pB1,t+1,true,true,true);   WAITX(2,true); RESC(); ROT();
  }
  #define ENDW(tt) do{ if((tt)+3<NT){WAITX(2,true);} else if((tt)+2<NT){WAITX(1,false);} else {WAITX(0,false);} }while(0)
  for(;t+1<NT;t+=2){
    STEP(pB0,pB1,pA0,pA1,t,(t+3<NT),(t+1<NT),(t+1<NT));       ENDW(t);   RESC(); ROT();
    STEP(pA0,pA1,pB0,pB1,t+1,(t+4<NT),(t+2<NT),(t+2<NT));     ENDW(t+1); RESC(); ROT();
  }
  STEP(pB0,pB1,pA0,pA1,NT-1,false,false,false); RESC();
  { float sacc=pB0[0]+pB0[1]; _Pragma("unroll") for(int r=2;r<16;++r)sacc+=pB0[r]; _Pragma("unroll") for(int r=0;r<16;++r)sacc+=pB1[r]; l_reg+=sacc;
    pw0=(u32x4){PKW(pB0,0),PKW(pB0,2),PKW(pB0,4),PKW(pB0,6)};pw1=(u32x4){PKW(pB0,8),PKW(pB0,10),PKW(pB0,12),PKW(pB0,14)};pw2=(u32x4){PKW(pB1,0),PKW(pB1,2),PKW(pB1,4),PKW(pB1,6)};pw3=(u32x4){PKW(pB1,8),PKW(pB1,10),PKW(pB1,12),PKW(pB1,14)};
    SBAR(); pv(o,vb0+sl_cur,PAF(0),PAF(1),PAF(2),PAF(3)); }
  #undef PKW
  #undef PAF
  #undef VFR
  #undef PIN
  #undef MX3
  #undef GAPA
  #undef GAPB
  #undef EX
  #undef VRD
  #undef KRD
  #undef KRDX
  #undef XMF
  #undef STEP
  #undef ENDW
  {auto rr=__builtin_amdgcn_permlane32_swap(__float_as_uint(l_reg),__float_as_uint(l_reg),false,false);l_reg=__uint_as_float(rr[0])+__uint_as_float(rr[1]);}
  if(hi==0)wsf[32+r32]=l_reg;asm volatile("s_waitcnt lgkmcnt(0)":::"memory");
  float rli[16];
  #pragma unroll
  for(int r=0;r<16;++r)rli[r]=__builtin_amdgcn_rcpf(wsf[32+crow(r,hi)]);
  bf16*Ow=O+(rowbase+q0+wid*QBLK)*DM+h*D;
  { bf16*stg=(bf16*)(shm+LDS_OST)+wid*2048;
    #pragma unroll
    for(int r=0;r<16;++r){const int orow=crow(r,hi);
      #pragma unroll
      for(int d0=0;d0<2;++d0)stg[orow*64+d0*32+r32]=__float2bfloat16(o[d0][r]*rli[r]);}
    asm volatile("s_waitcnt lgkmcnt(0)":::"memory");
    #pragma unroll
    for(int i=0;i<4;++i){const int row=i*8+(lane>>3),ch=lane&7; const u32x4 v=*(const u32x4*)(stg+row*64+ch*8); ATTN_STORE16(Ow+(long)row*DM+ch*8,v);} }
  asm volatile("s_waitcnt lgkmcnt(0)\n\ts_barrier":::"memory");
  #undef DMA_K
  #undef DMA_V
  #undef PT
  #undef WAITX
  #undef CMASK
  #undef BLKSEL
  #undef START
  #undef SETREF
  #undef RESC
  #undef ROT
}
constexpr int ATTN_LDS_BYTES=LDS_BYTES;
template<int THRL=8> __device__ __forceinline__ void attn_phase(char*lds,int vcu,const bf16*Q,const bf16*K,const bf16*V,bf16*O,const bf16*XK,const bf16*XQ,const float*kmean){
  const int bh=(2*vcu)>>3, b=bh/NHEAD, h=bh%NHEAD;
  if(bh>=BATCH*NHEAD)return;
#if !defined(ATTN_ONLY_MOBA)
  if(h<8){ for(int i=0;i<4;++i){ const int s=(2*vcu+(i>>1))&7,qb=(i&1)?15-s:s; attn_unit<THRL,true>(b,h,qb,Q,K,V,O,lds,XK,XQ,kmean); } }
#endif
#if !defined(ATTN_ONLY_FOX)
  if(h>=8){ for(int i=0;i<4;++i){ const int s=(2*vcu+(i>>1))&7,qb=(i&1)?15-s:s; attn_unit<THRL,false>(b,h,qb,Q,K,V,O,lds,XK,XQ,kmean); } }
#endif
}
#undef SBAR
#undef WAIT_BAR
#undef LDSV8
}

struct Frame {
    LAS unsigned char* lds;
    volatile LAS unsigned* MISC;
    gu32* ctl;
    int tid, lane, wave;
    int vcu, G;
    const float* const* in;
};
__device__ __forceinline__ float bf2f(unsigned short u) { return __uint_as_float((unsigned)u << 16); }
__device__ __forceinline__ float bflo(unsigned w) { return __uint_as_float(w << 16); }
__device__ __forceinline__ float bfhi(unsigned w) { return __uint_as_float(w & 0xffff0000u); }
__device__ __forceinline__ float wave_sum(float v) {
#pragma unroll
    for (int o = 1; o < 64; o <<= 1) v += __shfl_xor(v, o);
    return v;
}
__device__ __forceinline__ float wave_max(float v) {
#pragma unroll
    for (int o = 1; o < 64; o <<= 1) v = fmaxf(v, __shfl_xor(v, o));
    return v;
}
__device__ __forceinline__ float sigm(float x) { return 1.f / (1.f + __expf(-x)); }

__device__ __forceinline__ void p_mod(const Frame& F, const float* c, const float* mod_w, const float* mod_b, float* mod) {
    LAS float* cond = (LAS float*)(F.lds);
    LAS float* red = (LAS float*)(F.lds + 16384);
    for (int i = F.tid; i < BATCH * D; i += NTHR) { const float v = c[i]; cond[i] = v * sigm(v); }
    __syncthreads();
    for (int item = F.vcu; item < 2 * (MOD6 / 64); item += F.G) {
        const int l = item / (MOD6 / 64), n0 = (item % (MOD6 / 64)) * 64, col = n0 + F.lane, ks = F.wave;
        const float* wp = mod_w + ((size_t)l * D + ks * 128) * MOD6 + col;
        float a0 = 0.f, a1 = 0.f, a2 = 0.f, a3 = 0.f;
#pragma unroll 8
        for (int k = 0; k < 128; ++k) { const float w = wp[(size_t)k * MOD6]; const int kk = ks * 128 + k;
            a0 += cond[kk] * w; a1 += cond[D + kk] * w; a2 += cond[2 * D + kk] * w; a3 += cond[3 * D + kk] * w; }
        red[(ks * 4 + 0) * 64 + F.lane] = a0; red[(ks * 4 + 1) * 64 + F.lane] = a1; red[(ks * 4 + 2) * 64 + F.lane] = a2; red[(ks * 4 + 3) * 64 + F.lane] = a3;
        __syncthreads();
        if (F.tid < 256) { const int b = F.tid >> 6, cl = F.tid & 63; float s = 0.f;
#pragma unroll
            for (int k = 0; k < 8; ++k) s += red[(k * 4 + b) * 64 + cl];
            mod[((size_t)l * BATCH + b) * MOD6 + n0 + cl] = s + mod_b[(size_t)l * MOD6 + n0 + cl]; }
        __syncthreads();
    }
}

enum { RM_ID = 0, RM_QKV = 1, RM_SWIGLU = 2 };
__device__ __forceinline__ int rowmap(int mode, int n) {
    if (mode == RM_QKV) { const int i = n >> 9, j = n & 511; return (i % 3) * 1024 + (i / 3) * 512 + j; }
    if (mode == RM_SWIGLU) { const int up = n >= DFF, j = up ? n - DFF : n; return (j >> 7) * 256 + up * 128 + (j & 127); }
    return n;
}
__device__ __forceinline__ void transpose_item(const float* W, int ldw, int Ksrc, int k0, int n0, bf16* WT, int Kd, int kdst0, int rmode, int row_off,
                                               const float* mu, int mumode, LAS float* scr, int lane) {
#pragma unroll 8
    for (int i = 0; i < 32; ++i) { const int kk = 2 * i + (lane >> 5), k = k0 + kk; float v = 0.f;
        if (k < Ksrc) { v = W[(size_t)k * ldw + n0 + (lane & 31)]; if (mumode == 1) v *= mu[k]; else if (mumode == 2) v *= (1.f - mu[k]); }
        scr[kk * 33 + (lane & 31)] = v; }
    LDS_WAIT(); asm volatile("" ::: "memory");
    const int c = lane & 7;
#pragma unroll
    for (int j = 0; j < 4; ++j) { const int n = (lane >> 3) + 8 * j; const LAS float* s = scr + (8 * c) * 33 + n;
        v4u o; o.x = pk2(s[0 * 33], s[1 * 33]); o.y = pk2(s[2 * 33], s[3 * 33]); o.z = pk2(s[4 * 33], s[5 * 33]); o.w = pk2(s[6 * 33], s[7 * 33]);
        *(GAS v4u*)(WT + (size_t)(row_off + rowmap(rmode, n0 + n)) * Kd + kdst0 + k0 + 8 * c) = o; }
    LDS_WAIT(); asm volatile("" ::: "memory");
}
struct ConvJob { const float* W; int ldw, Ksrc, Kitems  , Nitems  ; bf16* WT; int Kd, kdst0, rmode, row_off; const float* mu; int mumode; };
__device__ __forceinline__ bool conv_run(const ConvJob& j, int& r, LAS float* scr, int lane) {
    const int cnt = j.Kitems * j.Nitems;
    if (r >= cnt) { r -= cnt; return false; }
    const int kb = r / j.Nitems, nb = r % j.Nitems;
    transpose_item(j.W, j.ldw, j.Ksrc, 64 * kb, 32 * nb, j.WT, j.Kd, j.kdst0, j.rmode, j.row_off, j.mu, j.mumode, scr, lane);
    return true;
}

__device__ __forceinline__ void norm_row(const float* xrow, bf16* orow, const float* g, const float* shift, const float* scale, int lane, f32x4 (&h)[4]) {
    const GAS f32x4* xr = (const GAS f32x4*)xrow + lane;
    f32x4 v[4]; float s = 0.f;
#pragma unroll
    for (int j = 0; j < 4; ++j) { v[j] = xr[64 * j]; s += (v[j].x * v[j].x + v[j].y * v[j].y) + (v[j].z * v[j].z + v[j].w * v[j].w); }
    const float inv = 1.f / sqrtf(wave_sum(s) * (1.f / D) + NORM_EPS);
    GAS unsigned long long* o8 = (GAS unsigned long long*)orow + lane;
#pragma unroll
    for (int j = 0; j < 4; ++j) { const int col = 4 * lane + 256 * j;
        const f32x4 gg = *(const f32x4*)(g + col), sh = *(const f32x4*)(shift + col), sc = *(const f32x4*)(scale + col);
        h[j] = (v[j] * inv * gg) * (1.f + sc) + sh;
        o8[64 * j] = (unsigned long long)pk2(h[j].x, h[j].y) | ((unsigned long long)pk2(h[j].z, h[j].w) << 32); }
}

template <int CTRL> __device__ __forceinline__ float dppf(float v) { return __builtin_bit_cast(float, __builtin_amdgcn_update_dpp(0, __builtin_bit_cast(int, v), CTRL, 0xF, 0xF, true)); }
__device__ __forceinline__ float sum4(float v) { v += dppf<0xB1>(v); v += dppf<0x4E>(v); return v; }
__device__ __forceinline__ float sum8(float v) { v = sum4(v); v += dppf<0x141>(v); return v; }
__device__ __forceinline__ float sum16(float v) { v = sum8(v); v += dppf<0x140>(v); return v; }
__device__ __forceinline__ void scan_chain_half(const Frame& F, int item, const bf16* Rb, const bf16* Kb, const bf16* Vb, const bf16* LWb, const bf16* Ab,
                                                const float* w0, const float* a0, const float* k_k, const float* k_a, const float* r_k, bf16* Yb, float* bonus) {
    const int chain = item >> 1, half = item & 1, b = chain >> 4, h = chain & 15, tid = F.tid;
    LAS float* sR = (LAS float*)F.lds; LAS float* sW = sR + 4096; LAS float* sK = sW + 4096; LAS float* sA = sK + 4096; LAS float* sB = sA + 4096; LAS float* sV = sB + 4096; LAS float* sY = sV + 2048;
    float S0 = 0.f, S1 = 0.f, S2 = 0.f, S3 = 0.f;
    const int prow = tid >> 3, psub = tid & 7, colh = h * HD + 8 * psub;
    const int srow = tid >> 4, ssub = tid & 15;
    float kkw[8], kaw[8], rkw[8], w0v[8], a0v[8];
#pragma unroll
    for (int j = 0; j < 8; ++j) { kkw[j] = k_k[colh + j]; kaw[j] = k_a[colh + j]; rkw[j] = r_k[colh + j]; w0v[j] = w0[colh + j]; a0v[j] = a0[colh + j]; }
#define UNP(dst, src) dst[0] = bflo(src.x); dst[1] = bfhi(src.x); dst[2] = bflo(src.y); dst[3] = bfhi(src.y); dst[4] = bflo(src.z); dst[5] = bfhi(src.z); dst[6] = bflo(src.w); dst[7] = bfhi(src.w);
    for (int ch = 0; ch < SEQ / 64; ++ch) {
        const size_t grow = (size_t)b * SEQ + ch * 64 + prow;
        const size_t goff = grow * D + colh;
        {
            const v4u r8 = *(const GAS v4u*)(Rb + goff), k8 = *(const GAS v4u*)(Kb + goff), w8 = *(const GAS v4u*)(LWb + goff), a8 = *(const GAS v4u*)(Ab + goff);
            float rr[8], kr[8], lw[8], aa[8];
            UNP(rr, r8) UNP(kr, k8) UNP(lw, w8) UNP(aa, a8)
            float kkv[8], ss = 0.f, rk = 0.f;
#pragma unroll
            for (int j = 0; j < 8; ++j) { lw[j] = -0.6065306597126334f * sigm(w0v[j] + lw[j]); aa[j] = sigm(a0v[j] + aa[j]); kkv[j] = kr[j] * kkw[j]; ss += kkv[j] * kkv[j]; }
            ss = sum8(ss);
            const float inv = 1.f / fmaxf(sqrtf(ss), 1e-12f);
            const int lo = prow * 64 + 8 * psub;
#pragma unroll
            for (int j = 0; j < 8; ++j) { const float kk = kkv[j] * inv, km = kr[j] * (1.f + (aa[j] - 1.f) * kaw[j]);
                sR[lo + j] = rr[j]; sW[lo + j] = __expf(lw[j]); sK[lo + j] = km; sA[lo + j] = -kk; sB[lo + j] = kk * aa[j]; rk += rr[j] * km * rkw[j]; }
            rk = sum8(rk);
            if (half == 0 && psub == 0) bonus[grow * NH + h] = rk;
            const unsigned long long v4 = *(const GAS unsigned long long*)(Vb + grow * D + h * HD + 32 * half + 4 * psub);
            *(LAS f32x4*)(sV + prow * 32 + 4 * psub) = (f32x4){bflo((unsigned)v4), bfhi((unsigned)v4), bflo((unsigned)(v4 >> 32)), bfhi((unsigned)(v4 >> 32))};
        }
        __syncthreads();
#pragma unroll 2
        for (int tt = 0; tt < 64; ++tt) {
            const int lo = tt * 64 + 4 * ssub;
            const f32x4 a4 = *(const LAS f32x4*)(sA + lo), b4 = *(const LAS f32x4*)(sB + lo), w4 = *(const LAS f32x4*)(sW + lo), k4 = *(const LAS f32x4*)(sK + lo), r4 = *(const LAS f32x4*)(sR + lo);
            const float vi = sV[tt * 32 + srow];
            const float sa = sum16((S0 * a4.x + S1 * a4.y) + (S2 * a4.z + S3 * a4.w));
            S0 = S0 * w4.x + (sa * b4.x + vi * k4.x); S1 = S1 * w4.y + (sa * b4.y + vi * k4.y); S2 = S2 * w4.z + (sa * b4.z + vi * k4.z); S3 = S3 * w4.w + (sa * b4.w + vi * k4.w);
            const float y = sum16((S0 * r4.x + S1 * r4.y) + (S2 * r4.z + S3 * r4.w));
            if (ssub == 0) sY[tt * 32 + srow] = y;
        }
        __syncthreads();
        {
            const f32x4 y4 = *(const LAS f32x4*)(sY + prow * 32 + 4 * psub);
            *(GAS unsigned long long*)(Yb + grow * D + h * HD + 32 * half + 4 * psub) = (unsigned long long)pk2(y4.x, y4.y) | ((unsigned long long)pk2(y4.z, y4.w) << 32);
        }
        __syncthreads();
    }
#undef UNP
}
__device__ __forceinline__ void rwkv_post_row(size_t m, bf16* Yb, const bf16* Vb, const bf16* Gb, const float* bonus, const float (&lnw)[16], const float (&lnb)[16], int lane) {
    const size_t off = m * D + 16 * lane;
    const v4u y0 = *(const GAS v4u*)(Yb + off), y1 = *(const GAS v4u*)(Yb + off + 8), v0 = *(const GAS v4u*)(Vb + off), v1 = *(const GAS v4u*)(Vb + off + 8), g0 = *(const GAS v4u*)(Gb + off), g1 = *(const GAS v4u*)(Gb + off + 8);
    float y[16], v[16], g[16];
#define UNP8(dst, o, src) dst[o] = bflo(src.x); dst[o + 1] = bfhi(src.x); dst[o + 2] = bflo(src.y); dst[o + 3] = bfhi(src.y); dst[o + 4] = bflo(src.z); dst[o + 5] = bfhi(src.z); dst[o + 6] = bflo(src.w); dst[o + 7] = bfhi(src.w);
    UNP8(y, 0, y0) UNP8(y, 8, y1) UNP8(v, 0, v0) UNP8(v, 8, v1) UNP8(g, 0, g0) UNP8(g, 8, g1)
#undef UNP8
    float s = 0.f;
#pragma unroll
    for (int j = 0; j < 16; ++j) s += y[j];
    const float mean = sum4(s) * (1.f / 64.f); float q = 0.f;
#pragma unroll
    for (int j = 0; j < 16; ++j) { const float d = y[j] - mean; q += d * d; }
    const float rstd = 1.f / sqrtf(sum4(q) * (1.f / 64.f) + GN_EPS), bs = bonus[m * NH + (lane >> 2)];
    float o[16];
#pragma unroll
    for (int j = 0; j < 16; ++j) o[j] = ((y[j] - mean) * rstd * lnw[j] + lnb[j] + bs * v[j]) * g[j];
    v4u w0, w1; w0.x = pk2(o[0], o[1]); w0.y = pk2(o[2], o[3]); w0.z = pk2(o[4], o[5]); w0.w = pk2(o[6], o[7]); w1.x = pk2(o[8], o[9]); w1.y = pk2(o[10], o[11]); w1.z = pk2(o[12], o[13]); w1.w = pk2(o[14], o[15]);
    *(GAS v4u*)(Yb + off) = w0; *(GAS v4u*)(Yb + off + 8) = w1;
}

namespace rw {
typedef short bf16x8 __attribute__((ext_vector_type(8)));
typedef short bf16x4 __attribute__((ext_vector_type(4)));
typedef float f32x16 __attribute__((ext_vector_type(16)));
typedef float f32x4 __attribute__((ext_vector_type(4)));
typedef unsigned u32x2 __attribute__((ext_vector_type(2)));
typedef unsigned u32x4 __attribute__((ext_vector_type(4)));
#define RW_LAS __attribute__((address_space(3)))
#define MK4(a, b, c, d) ((u32x4){(unsigned)(a), (unsigned)(b), (unsigned)(c), (unsigned)(d)})
__device__ __forceinline__ int crow(int r, int hi) { return (r & 3) + 8 * (r >> 2) + 4 * hi; }
__device__ __forceinline__ int ioff(int row, int col) { return row * 128 + ((col * 2) ^ ((row & 7) << 4)); }
__device__ __forceinline__ unsigned pk(float lo, float hi) { typedef float f2 __attribute__((ext_vector_type(2))); typedef __bf16 b2 __attribute__((ext_vector_type(2))); f2 v = {lo, hi}; b2 b = __builtin_convertvector(v, b2); return __builtin_bit_cast(unsigned, b); }
__device__ __forceinline__ unsigned short bf1(float x) { return (unsigned short)(pk(x, 0.f) & 0xffffu); }
__device__ __forceinline__ float bf2f_(unsigned short u) { return __uint_as_float((unsigned)u << 16); }
enum { S_BH = 0, S_KH, S_AH, S_RH, S_AHT, S_BTT, S_KTT, S_VT, S_NF  , S_NF2, S_AAK, S_ABR, S_AKRT, S_N, S_T, S_TT };
typedef RW_LAS unsigned char* lptr;
__device__ __forceinline__ f32x16 mma(lptr L, int lrow0, lptr R, int rrow0, int kb, int ke, int r, int h) {
    asm volatile("" : "+v"(r), "+v"(h));
    f32x16 acc = {};
    for (int ks = kb; ks < ke; ++ks) {
        const bf16x8 a = *(const RW_LAS bf16x8*)(L + ioff(lrow0 + r, 16 * ks + 8 * h));
        const bf16x8 b = *(const RW_LAS bf16x8*)(R + ioff(rrow0 + r, 16 * ks + 8 * h));
        acc = __builtin_amdgcn_mfma_f32_32x32x16_bf16(a, b, acc, 0, 0, 0);
    }
    return acc;
}
__device__ __forceinline__ void store_cr(const f32x16& acc, lptr img, int drow0, int dcol0, int r, int h) {
    asm volatile("" : "+v"(r), "+v"(h));
#pragma unroll
    for (int g = 0; g < 4; ++g) { u32x2 w; w.x = pk(acc[4 * g], acc[4 * g + 1]); w.y = pk(acc[4 * g + 2], acc[4 * g + 3]);
        *(RW_LAS u32x2*)(img + ioff(dcol0 + r, drow0 + 8 * g + 4 * h)) = w; }
}
__device__ __forceinline__ void add_cr(f32x16& acc, lptr img, int drow0, int dcol0, int r, int h) {
    asm volatile("" : "+v"(r), "+v"(h));
#pragma unroll
    for (int g = 0; g < 4; ++g) { const u32x2 w = *(const RW_LAS u32x2*)(img + ioff(dcol0 + r, drow0 + 8 * g + 4 * h));
        acc[4 * g] += __uint_as_float(w.x << 16); acc[4 * g + 1] += __uint_as_float(w.x & 0xffff0000u); acc[4 * g + 2] += __uint_as_float(w.y << 16); acc[4 * g + 3] += __uint_as_float(w.y & 0xffff0000u); }
}
__device__ __forceinline__ void zero_tile_cr(lptr img, int drow0, int dcol0, int r, int h) {
    asm volatile("" : "+v"(r), "+v"(h));
#pragma unroll
    for (int g = 0; g < 4; ++g) *(RW_LAS u32x2*)(img + ioff(dcol0 + r, drow0 + 8 * g + 4 * h)) = (u32x2){0u, 0u};
}
__device__ __forceinline__ float sigm_(float x) { return 1.f / (1.f + __expf(-x)); }
template <int CTRL> __device__ __forceinline__ float dpp_(float v) { return __builtin_bit_cast(float, __builtin_amdgcn_update_dpp(0, __builtin_bit_cast(int, v), CTRL, 0xF, 0xF, true)); }
__device__ __forceinline__ float sum8_(float v) { v += dpp_<0xB1>(v); v += dpp_<0x4E>(v); v += dpp_<0x141>(v); return v; }

__device__ __forceinline__ void r1_item(lptr lds, int item, unsigned short* Rb, unsigned short* Kb, const unsigned short* Vb, unsigned short* LWb, unsigned short* Ab,
                                        const float* w0, const float* a0, const float* k_k, const float* k_a, const float* r_k, float* bonus) {
    int tid = threadIdx.x; asm volatile("" : "+v"(tid));
    const int lane = tid & 63, wid = __builtin_amdgcn_readfirstlane(tid >> 6);
#define RW_LANE() int ln_ = lane; asm volatile("" : "+v"(ln_)); const int r = ln_ & 31, h = ln_ >> 5; (void)r; (void)h;
    const int chunk = item >> 4, hd = item & 15;
    const size_t row0 = (size_t)chunk * 64;
    lptr SL[16];
#pragma unroll
    for (int i = 0; i < 16; ++i) SL[i] = lds + i * 8192;
    RW_LAS float* wtot = (RW_LAS float*)(lds + 131072 + 2048);
    RW_LAS float* gam = (RW_LAS float*)(lds + 131072 + 1024);
    const int tok = tid >> 3, sub = tid & 7, c0 = 8 * sub, colh = hd * 64 + c0;
    const size_t goff = (row0 + tok) * 1024 + colh;
    float lw[8], g[8], av[8], bv[8], km[8], rr[8], vv[8];
    {
        const u32x4 r8 = *(const u32x4*)(Rb + goff), k8 = *(const u32x4*)(Kb + goff), v8 = *(const u32x4*)(Vb + goff), w8 = *(const u32x4*)(LWb + goff), a8 = *(const u32x4*)(Ab + goff);
        float kr[8], aa[8];
#define RW_UNP(dst, src) dst[0] = __uint_as_float(src.x << 16); dst[1] = __uint_as_float(src.x & 0xffff0000u); dst[2] = __uint_as_float(src.y << 16); dst[3] = __uint_as_float(src.y & 0xffff0000u); \
                         dst[4] = __uint_as_float(src.z << 16); dst[5] = __uint_as_float(src.z & 0xffff0000u); dst[6] = __uint_as_float(src.w << 16); dst[7] = __uint_as_float(src.w & 0xffff0000u);
        RW_UNP(rr, r8) RW_UNP(kr, k8) RW_UNP(vv, v8) RW_UNP(lw, w8) RW_UNP(aa, a8)
#undef RW_UNP
        float kkv[8], ss = 0.f, rk = 0.f;
#pragma unroll
        for (int e = 0; e < 8; ++e) { lw[e] = -0.6065306597126334f * sigm_(w0[colh + e] + lw[e]); aa[e] = sigm_(a0[colh + e] + aa[e]); kkv[e] = kr[e] * k_k[colh + e]; ss += kkv[e] * kkv[e]; }
        ss = sum8_(ss);
        const float inv = 1.f / fmaxf(sqrtf(ss), 1e-12f);
#pragma unroll
        for (int e = 0; e < 8; ++e) { const float kk = kkv[e] * inv; km[e] = kr[e] * (1.f + (aa[e] - 1.f) * k_a[colh + e]); av[e] = -kk; bv[e] = kk * aa[e]; rk += rr[e] * km[e] * r_k[colh + e]; }
        rk = sum8_(rk);
        if (sub == 0) bonus[(row0 + tok) * 16 + hd] = rk;
#pragma unroll
        for (int e = 0; e < 8; ++e) { float x = lw[e];
#pragma unroll
            for (int o = 8; o < 64; o <<= 1) { const float y = __shfl_up(x, o); if (lane >= o) x += y; }
            g[e] = x; }
        if (lane >= 56) {
#pragma unroll
            for (int e = 0; e < 8; ++e) wtot[wid * 64 + c0 + e] = g[e]; }
    }
    __syncthreads();
    float gC[8];
    {
#pragma unroll
        for (int e = 0; e < 8; ++e) { float pre = 0.f, tot = 0.f;
#pragma unroll
            for (int w = 0; w < 8; ++w) { const float x = wtot[w * 64 + c0 + e]; tot += x; if (w < wid) pre += x; }
            g[e] += pre; gC[e] = tot; }
    }
    {
        unsigned short xbh[8], xkh[8], xah[8], xrh[8], xbt[8], xkt[8], xv[8];
#pragma unroll
        for (int e = 0; e < 8; ++e) { const float eg = __expf(g[e]), egm1 = __expf(g[e] - lw[e]), eng = __expf(-g[e]), egc = __expf(gC[e] - g[e]);
            xah[e] = bf1(av[e] * egm1); xrh[e] = bf1(rr[e] * eg); xbh[e] = bf1(bv[e] * eng); xkh[e] = bf1(km[e] * eng); xbt[e] = bf1(bv[e] * egc); xkt[e] = bf1(km[e] * egc); xv[e] = bf1(vv[e]); }
#define RW_ST8(slot, x) *(RW_LAS u32x4*)(SL[slot] + ioff(tok, c0)) = MK4(x[0] | ((unsigned)x[1] << 16), x[2] | ((unsigned)x[3] << 16), x[4] | ((unsigned)x[5] << 16), x[6] | ((unsigned)x[7] << 16));
        RW_ST8(S_BH, xbh) RW_ST8(S_KH, xkh) RW_ST8(S_AH, xah) RW_ST8(S_RH, xrh)
#undef RW_ST8
#pragma unroll
        for (int e = 0; e < 8; ++e) { *(RW_LAS unsigned short*)(SL[S_AHT] + ioff(c0 + e, tok)) = xah[e]; *(RW_LAS unsigned short*)(SL[S_BTT] + ioff(c0 + e, tok)) = xbt[e];
            *(RW_LAS unsigned short*)(SL[S_KTT] + ioff(c0 + e, tok)) = xkt[e]; *(RW_LAS unsigned short*)(SL[S_VT] + ioff(c0 + e, tok)) = xv[e]; }
    }
    if (tok == 0) {
#pragma unroll
        for (int e = 0; e < 8; ++e) gam[c0 + e] = __expf(gC[e]); }
    __syncthreads();
    if (wid == 0) {
        RW_LAS float* Nf = (RW_LAS float*)SL[S_NF];
        { RW_LANE()
#pragma unroll
        for (int t4 = 0; t4 < 4; ++t4) { const int bi = t4 >> 1, bj = t4 & 1;
            f32x16 acc = {};
            if (bi <= bj) acc = mma(SL[S_BH], 32 * bi, SL[S_AH], 32 * bj, 0, 4, r, h);
#pragma unroll
            for (int q = 0; q < 16; ++q) { const int s = 32 * bi + crow(q, h), u = 32 * bj + r; const float val = (s < u) ? acc[q] : 0.f;
                Nf[s * 64 + u] = val; *(RW_LAS unsigned short*)(SL[S_N] + ioff(s, u)) = bf1(val); } }
        }
#pragma unroll
        for (int i = 0; i < 8; ++i) { *(RW_LAS u32x4*)(SL[S_T] + (i * 64 + lane) * 16) = MK4(0u, 0u, 0u, 0u); *(RW_LAS u32x4*)(SL[S_TT] + (i * 64 + lane) * 16) = MK4(0u, 0u, 0u, 0u); }
        asm volatile("s_waitcnt lgkmcnt(0)" ::: "memory");
        { int l2_ = lane; asm volatile("" : "+v"(l2_)); const int d = l2_ >> 4, c = l2_ & 15; float Tc[16];
#pragma unroll
          for (int u = 0; u < 16; ++u) Tc[u] = (u == c) ? 1.f : 0.f;
          const RW_LAS float* nb = Nf + (16 * d) * 64 + 16 * d;
#pragma unroll
          for (int s = 14; s >= 0; --s) { const RW_LAS float* nr = nb + s * 64; float a = (s == c) ? 1.f : 0.f;
#pragma unroll
              for (int u4 = 0; u4 < 4; ++u4) { if (4 * u4 + 3 > s) { const f32x4 n4 = *(const RW_LAS f32x4*)(nr + 4 * u4);
#pragma unroll
                  for (int e = 0; e < 4; ++e) if (4 * u4 + e > s) a += n4[e] * Tc[4 * u4 + e]; } }
              Tc[s] = a; }
          *(RW_LAS u32x4*)(SL[S_TT] + ioff(16 * d + c, 16 * d)) = MK4(pk(Tc[0], Tc[1]), pk(Tc[2], Tc[3]), pk(Tc[4], Tc[5]), pk(Tc[6], Tc[7]));
          *(RW_LAS u32x4*)(SL[S_TT] + ioff(16 * d + c, 16 * d + 8)) = MK4(pk(Tc[8], Tc[9]), pk(Tc[10], Tc[11]), pk(Tc[12], Tc[13]), pk(Tc[14], Tc[15]));
#pragma unroll
          for (int u = 0; u < 16; ++u) *(RW_LAS unsigned short*)(SL[S_T] + ioff(16 * d + u, 16 * d + c)) = bf1(Tc[u]); }
        asm volatile("s_waitcnt lgkmcnt(0)" ::: "memory");
        lptr Q1T = SL[S_NF];
        RW_LANE()
#pragma unroll
        for (int I = 0; I < 2; ++I) {
            f32x16 q1 = mma(SL[S_N], 32 * I, SL[S_TT], 32 * I, 2 * I + 1, 2 * I + 2, r, h);
            store_cr(q1, Q1T, 0, 0, r, h);
            asm volatile("s_waitcnt lgkmcnt(0)" ::: "memory");
            f32x16 q2 = {};
            { const bf16x8 a = *(const RW_LAS bf16x8*)(SL[S_T] + ioff(32 * I + r, 32 * I + 8 * h)); const bf16x8 b = *(const RW_LAS bf16x8*)(Q1T + ioff(r, 8 * h));
              q2 = __builtin_amdgcn_mfma_f32_32x32x16_bf16(a, b, q2, 0, 0, 0); }
            if (r >= 16) {
#pragma unroll
                for (int q = 0; q < 8; ++q) *(RW_LAS unsigned short*)(SL[S_T] + ioff(32 * I + crow(q, h), 32 * I + r)) = bf1(q2[q]);
#pragma unroll
                for (int gq = 0; gq < 2; ++gq) { u32x2 w; w.x = pk(q2[4 * gq], q2[4 * gq + 1]); w.y = pk(q2[4 * gq + 2], q2[4 * gq + 3]); *(RW_LAS u32x2*)(SL[S_TT] + ioff(32 * I + r, 32 * I + 8 * gq + 4 * h)) = w; } }
            asm volatile("s_waitcnt lgkmcnt(0)" ::: "memory");
        }
        {
            f32x16 q1 = mma(SL[S_N], 0, SL[S_TT], 32, 2, 4, r, h);
            store_cr(q1, Q1T, 0, 0, r, h);
            asm volatile("s_waitcnt lgkmcnt(0)" ::: "memory");
            f32x16 q2 = mma(SL[S_T], 0, Q1T, 0, 0, 2, r, h);
#pragma unroll
            for (int q = 0; q < 16; ++q) *(RW_LAS unsigned short*)(SL[S_T] + ioff(crow(q, h), 32 + r)) = bf1(q2[q]);
            store_cr(q2, SL[S_TT], 0, 32, r, h);
        }
    } else {
        RW_LANE()
        for (int q = wid - 1; q < 12; q += 7) { const int mat = q >> 2, bi = (q >> 1) & 1, bj = q & 1;
            if (mat == 0) {
                if (bj > bi) { zero_tile_cr(SL[S_AAK], 32 * bi, 32 * bj, r, h); continue; }
                f32x16 acc = mma(SL[S_AH], 32 * bi, SL[S_KH], 32 * bj, 0, 4, r, h);
#pragma unroll
                for (int x = 0; x < 16; ++x) if (!(32 * bj + r < 32 * bi + crow(x, h))) acc[x] = 0.f;
                store_cr(acc, SL[S_AAK], 32 * bi, 32 * bj, r, h);
            } else if (mat == 1) {
                if (bi > bj) { zero_tile_cr(SL[S_ABR], 32 * bi, 32 * bj, r, h); continue; }
                f32x16 acc = mma(SL[S_BH], 32 * bi, SL[S_RH], 32 * bj, 0, 4, r, h);
#pragma unroll
                for (int x = 0; x < 16; ++x) if (!(32 * bi + crow(x, h) <= 32 * bj + r)) acc[x] = 0.f;
                store_cr(acc, SL[S_ABR], 32 * bi, 32 * bj, r, h);
            } else {
                if (bi > bj) { zero_tile_cr(SL[S_AKRT], 32 * bi, 32 * bj, r, h); continue; }
                f32x16 acc = mma(SL[S_KH], 32 * bi, SL[S_RH], 32 * bj, 0, 4, r, h);
#pragma unroll
                for (int x = 0; x < 16; ++x) if (!(32 * bi + crow(x, h) <= 32 * bj + r)) acc[x] = 0.f;
                store_cr(acc, SL[S_AKRT], 32 * bi, 32 * bj, r, h);
            }
        }
    }
    __syncthreads();
    { RW_LANE() const int bi = wid >> 2, bx = wid & 3;
      f32x16 acc = mma(SL[S_TT], 32 * bi, bx < 2 ? SL[S_AAK] : SL[S_AHT], 32 * (bx & 1), 0, 4, r, h);
      store_cr(acc, bx < 2 ? SL[S_BH] : SL[S_KH], 32 * bi, 32 * (bx & 1), r, h); }
    __syncthreads();
    { RW_LANE()
#pragma unroll
    for (int tt = 0; tt < 2; ++tt) { const int id = 2 * wid + tt, lsel = id >> 3, rsel = (id >> 2) & 1, bi = (id >> 1) & 1, bj = id & 1;
        f32x16 acc = mma(lsel ? SL[S_KH] : SL[S_BH], 32 * bi, rsel ? SL[S_BTT] : SL[S_ABR], 32 * bj, 0, 4, r, h);
        if (lsel == 0 && rsel == 0) { add_cr(acc, SL[S_AKRT], 32 * bi, 32 * bj, r, h); store_cr(acc, SL[S_AHT], 32 * bi, 32 * bj, r, h); }
        else if (lsel == 0) { add_cr(acc, SL[S_KTT], 32 * bi, 32 * bj, r, h); store_cr(acc, SL[S_NF], 32 * bi, 32 * bj, r, h); }
        else if (rsel == 0) { add_cr(acc, SL[S_RH], 32 * bi, 32 * bj, r, h); store_cr(acc, SL[S_N], 32 * bi, 32 * bj, r, h); }
        else { if (bi == bj) { const float gm = gam[32 * bj + r];
#pragma unroll
                   for (int x = 0; x < 16; ++x) if (crow(x, h) == r) acc[x] += gm; }
               store_cr(acc, SL[S_AAK], 32 * bi, 32 * bj, r, h); }
    } }
    __syncthreads();
    { RW_LANE() const int sel = wid >> 2, bi = (wid >> 1) & 1, bj = wid & 1;
      if (sel == 0) { f32x16 acc = mma(SL[S_NF], 32 * bi, SL[S_VT], 32 * bj, 0, 4, r, h); store_cr(acc, SL[S_AH], 32 * bi, 32 * bj, r, h); }
      else          { f32x16 acc = mma(SL[S_VT], 32 * bi, SL[S_AHT], 32 * bj, 0, 4, r, h); store_cr(acc, SL[S_ABR], 32 * bi, 32 * bj, r, h); } }
    __syncthreads();
    { const int row = tid >> 3, c16 = tid & 7; const size_t go = (row0 + row) * 1024 + hd * 64 + 8 * c16;
      *(u32x4*)(Rb + go) = *(const RW_LAS u32x4*)(SL[S_AAK] + ioff(row, 8 * c16));
      *(u32x4*)(Kb + go) = *(const RW_LAS u32x4*)(SL[S_N] + ioff(row, 8 * c16));
      *(u32x4*)(LWb + go) = *(const RW_LAS u32x4*)(SL[S_AH] + ioff(row, 8 * c16));
      *(u32x4*)(Ab + go) = *(const RW_LAS u32x4*)(SL[S_ABR] + ioff(row, 8 * c16)); }
    __syncthreads();
#undef RW_LANE
}

__device__ __forceinline__ void r2_item(int item, const unsigned short* MT, const unsigned short* NT, unsigned short* XS, int lane) {
    const int chain = item >> 1, half = item & 1, b = chain >> 4, hd = chain & 15, r = lane & 31, h = lane >> 5;
    f32x16 x0 = {}, x1 = {};
    const size_t rowb = (size_t)b * 4096;
    const size_t aoff = (size_t)r * 1024 + hd * 64 + 4 * h;
    const size_t noff = (size_t)(32 * half + r) * 1024 + hd * 64 + 4 * h;
    u32x2 A[2][2][4][2], Nn[2][2][4];
#define R2_LOAD(slot, c) do { const size_t row0_ = rowb + (size_t)(c) * 64; \
        _Pragma("unroll") for (int rt = 0; rt < 2; ++rt) { \
            _Pragma("unroll") for (int ks = 0; ks < 4; ++ks) { const unsigned short* p_ = MT + (row0_ + 32 * rt) * 1024 + aoff + 16 * ks; A[slot][rt][ks][0] = *(const u32x2*)p_; A[slot][rt][ks][1] = *(const u32x2*)(p_ + 8); } \
            _Pragma("unroll") for (int g = 0; g < 4; ++g) Nn[slot][rt][g] = *(const u32x2*)(NT + row0_ * 1024 + noff + 32 * rt + 8 * g); } } while (0)
#define R2_STEP(slot, c) do { const size_t row0_ = rowb + (size_t)(c) * 64; \
        bf16x8 xf[4]; \
        _Pragma("unroll") for (int ks = 0; ks < 4; ++ks) { const f32x16& xx = (ks < 2) ? x0 : x1; const int o = 8 * (ks & 1); \
            u32x4 w; w.x = pk(xx[o], xx[o + 1]); w.y = pk(xx[o + 2], xx[o + 3]); w.z = pk(xx[o + 4], xx[o + 5]); w.w = pk(xx[o + 6], xx[o + 7]); xf[ks] = __builtin_bit_cast(bf16x8, w); \
            *(u32x4*)(XS + (row0_ + lane) * 1024 + hd * 64 + 32 * half + 8 * ks) = w; } \
        f32x16 n0, n1; \
        _Pragma("unroll") for (int g = 0; g < 4; ++g) { const u32x2 a_ = Nn[slot][0][g], b_ = Nn[slot][1][g]; \
            n0[4 * g] = __uint_as_float(a_.x << 16); n0[4 * g + 1] = __uint_as_float(a_.x & 0xffff0000u); n0[4 * g + 2] = __uint_as_float(a_.y << 16); n0[4 * g + 3] = __uint_as_float(a_.y & 0xffff0000u); \
            n1[4 * g] = __uint_as_float(b_.x << 16); n1[4 * g + 1] = __uint_as_float(b_.x & 0xffff0000u); n1[4 * g + 2] = __uint_as_float(b_.y << 16); n1[4 * g + 3] = __uint_as_float(b_.y & 0xffff0000u); } \
        _Pragma("unroll") for (int ks = 0; ks < 4; ++ks) { \
            const u32x4 a0_ = MK4(A[slot][0][ks][0].x, A[slot][0][ks][0].y, A[slot][0][ks][1].x, A[slot][0][ks][1].y), a1_ = MK4(A[slot][1][ks][0].x, A[slot][1][ks][0].y, A[slot][1][ks][1].x, A[slot][1][ks][1].y); \
            n0 = __builtin_amdgcn_mfma_f32_32x32x16_bf16(__builtin_bit_cast(bf16x8, a0_), xf[ks], n0, 0, 0, 0); \
            n1 = __builtin_amdgcn_mfma_f32_32x32x16_bf16(__builtin_bit_cast(bf16x8, a1_), xf[ks], n1, 0, 0, 0); } \
        x0 = n0; x1 = n1; } while (0)
    R2_LOAD(0, 0);
    for (int c = 0; c < 64; c += 2) {
        R2_LOAD(1, c + 1);
        R2_STEP(0, c);
        if (c + 2 < 64) R2_LOAD(0, c + 2);
        R2_STEP(1, c + 1);
    }
#undef R2_LOAD
#undef R2_STEP
}

__device__ __forceinline__ void r3_item(int item, unsigned short* XSOut, const unsigned short* QT, const unsigned short* YL, const unsigned short* Vb, const unsigned short* Gb,
                                        const float* bonus, const float* ln_w, const float* ln_b, int lane) {
    const int chunk = item >> 4, hd = item & 15, r = lane & 31, h = lane >> 5;
    const size_t row0 = (size_t)chunk * 64;
    f32x16 acc[2][2];
    bf16x8 af[2][4];
#pragma unroll
    for (int hf = 0; hf < 2; ++hf)
#pragma unroll
        for (int ks = 0; ks < 4; ++ks) af[hf][ks] = __builtin_bit_cast(bf16x8, *(const u32x4*)(XSOut + (row0 + lane) * 1024 + hd * 64 + 32 * hf + 8 * ks));
#pragma unroll
    for (int ct = 0; ct < 2; ++ct) {
        const size_t trow = (row0 + 32 * ct + r) * 1024 + hd * 64;
#pragma unroll
        for (int hf = 0; hf < 2; ++hf)
#pragma unroll
            for (int g = 0; g < 4; ++g) { const u32x2 w = *(const u32x2*)(YL + trow + 32 * hf + 8 * g + 4 * h);
                acc[hf][ct][4 * g] = __uint_as_float(w.x << 16); acc[hf][ct][4 * g + 1] = __uint_as_float(w.x & 0xffff0000u); acc[hf][ct][4 * g + 2] = __uint_as_float(w.y << 16); acc[hf][ct][4 * g + 3] = __uint_as_float(w.y & 0xffff0000u); }
#pragma unroll
        for (int ks = 0; ks < 4; ++ks) { const u32x2 lo = *(const u32x2*)(QT + trow + 16 * ks + 4 * h), hi2 = *(const u32x2*)(QT + trow + 16 * ks + 4 * h + 8);
            const bf16x8 bq = __builtin_bit_cast(bf16x8, MK4(lo.x, lo.y, hi2.x, hi2.y));
            acc[0][ct] = __builtin_amdgcn_mfma_f32_32x32x16_bf16(af[0][ks], bq, acc[0][ct], 0, 0, 0);
            acc[1][ct] = __builtin_amdgcn_mfma_f32_32x32x16_bf16(af[1][ks], bq, acc[1][ct], 0, 0, 0); }
    }
#pragma unroll
    for (int ct = 0; ct < 2; ++ct) {
        const size_t tix = row0 + 32 * ct + r, trow = tix * 1024 + hd * 64;
        float s = 0.f;
#pragma unroll
        for (int hf = 0; hf < 2; ++hf)
#pragma unroll
            for (int q = 0; q < 16; ++q) s += acc[hf][ct][q];
        { auto rr = __builtin_amdgcn_permlane32_swap(__float_as_uint(s), __float_as_uint(s), false, false); s = __uint_as_float(rr[0]) + __uint_as_float(rr[1]); }
        const float mean = s * (1.f / 64.f); float qv = 0.f;
#pragma unroll
        for (int hf = 0; hf < 2; ++hf)
#pragma unroll
            for (int q = 0; q < 16; ++q) { const float d = acc[hf][ct][q] - mean; qv += d * d; }
        { auto rr = __builtin_amdgcn_permlane32_swap(__float_as_uint(qv), __float_as_uint(qv), false, false); qv = __uint_as_float(rr[0]) + __uint_as_float(rr[1]); }
        const float rstd = 1.f / sqrtf(qv * (1.f / 64.f) + 64e-5f), bs = bonus[tix * 16 + hd];
#pragma unroll
        for (int hf = 0; hf < 2; ++hf)
#pragma unroll
            for (int g = 0; g < 4; ++g) { const int i0 = 32 * hf + 8 * g + 4 * h;
                const u32x2 vw = *(const u32x2*)(Vb + trow + i0), gw = *(const u32x2*)(Gb + trow + i0);
                const f32x4 lw4 = *(const f32x4*)(ln_w + hd * 64 + i0), lb4 = *(const f32x4*)(ln_b + hd * 64 + i0);
                const float v0 = __uint_as_float(vw.x << 16), v1 = __uint_as_float(vw.x & 0xffff0000u), v2 = __uint_as_float(vw.y << 16), v3 = __uint_as_float(vw.y & 0xffff0000u);
                const float g0 = __uint_as_float(gw.x << 16), g1 = __uint_as_float(gw.x & 0xffff0000u), g2 = __uint_as_float(gw.y << 16), g3 = __uint_as_float(gw.y & 0xffff0000u);
                const float o0 = ((acc[hf][ct][4 * g] - mean) * rstd * lw4[0] + lb4[0] + bs * v0) * g0, o1 = ((acc[hf][ct][4 * g + 1] - mean) * rstd * lw4[1] + lb4[1] + bs * v1) * g1;
                const float o2 = ((acc[hf][ct][4 * g + 2] - mean) * rstd * lw4[2] + lb4[2] + bs * v2) * g2, o3 = ((acc[hf][ct][4 * g + 3] - mean) * rstd * lw4[3] + lb4[3] + bs * v3) * g3;
                u32x2 w; w.x = pk(o0, o1); w.y = pk(o2, o3); *(u32x2*)(XSOut + trow + i0) = w; }
    }
}
#undef RW_LAS
#undef MK4
}

enum { I_X = 0, I_C, I_AWIN, I_ABF, I_AWOUT, I_MU, I_WR, I_WK, I_WV, I_WO, I_W0, I_W1, I_W2, I_A0, I_A1, I_A2, I_G1, I_G2, I_KK, I_KA, I_RK, I_LNW, I_LNB,
       I_MODW, I_MODB, I_NMIX, I_NFFN, I_FWIN, I_FWOUT, I_NFIN, N_IN };
enum { PH_PRO = 0, PH_NORM0, PH_QKV, PH_KMEAN, PH_ATTN, PH_WOUT, PH_NORMF0, PH_FFIN0, PH_FFOUT0, PH_NORM1, PH_MIX, PH_RKV, PH_LORAUP, PH_R1, PH_R2, PH_R3, PH_WO, PH_NORMF1, PH_FFIN1, PH_FFOUT1, PH_FINAL, N_PHASES };
struct Args { const float* in[N_IN]; float* out; unsigned char* ws; int ph_lo, ph_hi, pad0, pad1; };

template <class Epi> __device__ __forceinline__ void run_gemm(const Frame& F, const bf16* A, int lda, int gap, const bf16* Bt, int N, int K, const Epi& E) {
    asm volatile("" : "+s"(K), "+s"(lda));
    pg8::Gemm g{A, Bt, M, N, K, lda, gap}; pg8::StaticOrder S; S.init(M, N, F.G, (int)blockIdx.x);
    pg8::gemm_phase<Epi, pg8::StaticOrder, true, true>(F.lds + RING_OFF, g, S, E);
}

__global__ void __launch_bounds__(NTHR, 2) mk_fwd(Args args) {
    extern __shared__ __attribute__((aligned(16))) unsigned char lds[];
    Frame F;
    F.lds = (LAS unsigned char*)lds;
    F.MISC = (volatile LAS unsigned*)(F.lds + MISC_OFF);
    F.tid = threadIdx.x; F.lane = F.tid & 63; F.wave = __builtin_amdgcn_readfirstlane(F.tid >> 6);
    F.G = gridDim.x; { const int bx = blockIdx.x; F.vcu = (F.G % 8 == 0) ? (bx % 8) * (F.G / 8) + bx / 8 : bx; }
    unsigned char* ws = args.ws;
    F.ctl = (gu32*)(ws + WS_CTL);
    for (int u = F.tid; u < (LDS_BYTES - LDSCTL_OFF) / 4; u += NTHR) ((LAS unsigned*)(F.lds + LDSCTL_OFF))[u] = 0u;
    __syncthreads();
    XcdBarrier bar; bar.bar = (unsigned*)(F.ctl + CW_BAR); bar.x = 0; bar.st = nullptr;
#if MK_ONE_LAUNCH
    bar = xcd_barrier_post((unsigned*)(F.ctl + CW_BAR), F.MISC + 8);
#define GRID_BAR() xcd_barrier(bar)
#else
#define GRID_BAR() do { } while (0)
#endif
    const int lo = args.ph_lo, hi = args.ph_hi;
#ifndef REPMASK
#define REPMASK 0u
#endif
#define REPEAT(k) for (int rep_ = 0; rep_ < 1 + (int)(((REPMASK) >> (k)) & 1u); ++rep_)
#ifndef PHMASK
#define PHMASK 0xffffffu
#endif
#define IN(k) ((((PHMASK) >> (k)) & 1u) && lo <= (k) && (k) < hi)
#define SEAM(k) do { if (IN(k) && IN((k) + 1)) GRID_BAR(); } while (0)
    const int gw = F.vcu * NWAVES + F.wave, NGW = F.G * NWAVES;
    const float* const* in = args.in;
    float* const mod = (float*)(ws + WS_MOD);
    float* const lsig = (float*)(ws + WS_LSIG);
    float* const kmean = (float*)(ws + WS_KMEAN);
    float* const xres = args.out;
    bf16* const A0 = (bf16*)(ws + WS_A0); bf16* const A1 = (bf16*)(ws + WS_A1); bf16* const A2 = (bf16*)(ws + WS_A2); bf16* const A3 = (bf16*)(ws + WS_A3);
    bf16* const A4 = (bf16*)(ws + WS_A4); bf16* const A5 = (bf16*)(ws + WS_A5); bf16* const AM1 = (bf16*)(ws + WS_AM1); bf16* const XN1G = (bf16*)(ws + WS_XN1G);

    if (IN(PH_PRO)) REPEAT(PH_PRO) {
        p_mod(F, in[I_C], in[I_MODW], in[I_MODB], mod);
        __syncthreads();
        LAS float* scr = (LAS float*)(F.lds + RING_OFF + F.wave * 16384);
        const float* mu = in[I_MU];
        int total = 0;
#define CJ_LIST(X) \
            X(in[I_AWIN], IN_COLS, D, 16, 96, WS_WQKV, D, 0, RM_QKV, 0, nullptr, 0) \
            X(in[I_AWOUT], D, D, 16, 32, WS_WOUT, D, 0, RM_ID, 0, nullptr, 0) \
            X(in[I_FWIN], 2 * DFF, D, 16, 176, WS_WF0IN, D, 0, RM_SWIGLU, 0, nullptr, 0) \
            X(in[I_FWIN] + (size_t)D * 2 * DFF, 2 * DFF, D, 16, 176, WS_WF1IN, D, 0, RM_SWIGLU, 0, nullptr, 0) \
            X(in[I_FWOUT], D, DFF, 44, 32, WS_WF0OUT, DFF, 0, RM_ID, 0, nullptr, 0) \
            X(in[I_FWOUT] + (size_t)DFF * D, D, DFF, 44, 32, WS_WF1OUT, DFF, 0, RM_ID, 0, nullptr, 0) \
            X(in[I_WR], D, D, 16, 32, WS_WR, D, 0, RM_ID, 0, nullptr, 0) \
            X(in[I_WK], D, D, 16, 32, WS_WK, D, 0, RM_ID, 0, nullptr, 0) \
            X(in[I_WV], D, D, 16, 32, WS_WV, D, 0, RM_ID, 0, nullptr, 0) \
            X(in[I_WO], D, D, 16, 32, WS_WO, D, 0, RM_ID, 0, nullptr, 0) \
            X(in[I_W1], 64, D, 16, 2, WS_WLD, 2 * D, 0, RM_ID, 0, mu + 1 * D, 1) \
            X(in[I_W1], 64, D, 16, 2, WS_WLD, 2 * D, D, RM_ID, 0, mu + 1 * D, 2) \
            X(in[I_A1], 64, D, 16, 2, WS_WLD, 2 * D, 0, RM_ID, 128, mu + 4 * D, 1) \
            X(in[I_A1], 64, D, 16, 2, WS_WLD, 2 * D, D, RM_ID, 128, mu + 4 * D, 2) \
            X(in[I_G1], 160, D, 16, 5, WS_WLD, 2 * D, 0, RM_ID, 256, mu + 5 * D, 1) \
            X(in[I_G1], 160, D, 16, 5, WS_WLD, 2 * D, D, RM_ID, 256, mu + 5 * D, 2) \
            X(in[I_W2], D, 64, 2, 32, WS_WW2, 128, 0, RM_ID, 0, nullptr, 0) \
            X(in[I_A2], D, 64, 2, 32, WS_WA2, 128, 0, RM_ID, 0, nullptr, 0) \
            X(in[I_G2], D, 160, 4, 32, WS_WG2, 256, 0, RM_ID, 0, nullptr, 0)
#define CJ_COUNT(W, ldw, Ks, Ki, Ni, WSO, Kd, kd0, rm, ro, mup, mm) total += (Ki) * (Ni);
        CJ_LIST(CJ_COUNT)
#define CJ_RUN(W, ldw, Ks, Ki, Ni, WSO, Kd, kd0, rm, ro, mup, mm) \
            if (r < (Ki) * (Ni)) { transpose_item(W, ldw, Ks, 64 * (r / (Ni)), 32 * (r % (Ni)), (bf16*)(ws + WSO), Kd, kd0, rm, ro, mup, mm, scr, F.lane); continue; } r -= (Ki) * (Ni);
        for (int it = gw; it < total; it += NGW) { int r = it;
            CJ_LIST(CJ_RUN) }
#undef CJ_LIST
#undef CJ_COUNT
#undef CJ_RUN
        { GAS v4u* wl = (GAS v4u*)(ws + WS_WLD); const v4u z = {0u, 0u, 0u, 0u};
          for (int i = blockIdx.x * NTHR + F.tid; i < 224 * 256; i += F.G * NTHR) { const int rr = i >> 8, c = i & 255; const int row = rr < 64 ? 64 + rr : (rr < 128 ? 192 + (rr - 64) : 416 + (rr - 128)); wl[(size_t)row * 256 + c] = z; } }
    }
    SEAM(PH_PRO);

    if (IN(PH_NORM0)) REPEAT(PH_NORM0) {
        LAS float* wf = (LAS float*)F.lds;
        for (int i = F.tid; i < D * 8; i += NTHR) wf[i] = in[I_AWIN][(size_t)(i >> 3) * IN_COLS + 3 * D + (i & 7)];
        __syncthreads();
        for (int m = gw; m < M; m += NGW) { const int b = m / SEQ; f32x4 h[4];
            const float* mb = mod + (size_t)b * MOD6;
            norm_row(in[I_X] + (size_t)m * D, A0 + (size_t)m * D, in[I_NMIX], mb, mb + D, F.lane, h);
            float f[8];
#pragma unroll
            for (int e = 0; e < 8; ++e) f[e] = 0.f;
#pragma unroll
            for (int j = 0; j < 4; ++j)
#pragma unroll
                for (int c = 0; c < 4; ++c) { const int col = 4 * F.lane + 256 * j + c; const float hv = h[j][c];
                    const f32x4 w0 = *(const LAS f32x4*)(wf + col * 8), w1 = *(const LAS f32x4*)(wf + col * 8 + 4);
                    f[0] += hv * w0.x; f[1] += hv * w0.y; f[2] += hv * w0.z; f[3] += hv * w0.w; f[4] += hv * w1.x; f[5] += hv * w1.y; f[6] += hv * w1.z; f[7] += hv * w1.w; }
            float mine = 0.f;
#pragma unroll
            for (int e = 0; e < 8; ++e) { const float s = wave_sum(f[e]); if (F.lane == e) mine = s; }
            if (F.lane < 8) { const float z = mine + in[I_ABF][F.lane]; const float ls = fminf(z, 0.f) - log1pf(__expf(-fabsf(z)));
                lsig[(size_t)(b * NFOX + F.lane) * SEQ + (m % SEQ)] = ls; }
        }
    }
    SEAM(PH_NORM0);

    if (IN(PH_QKV)) REPEAT(PH_QKV) {
        if (gw < BATCH * NFOX) {
            const float* lp = lsig + (size_t)gw * SEQ + 64 * F.lane; double s = 0.0;
            for (int i = 0; i < 64; ++i) s += (double)lp[i];
            double pre = s;
#pragma unroll
            for (int o = 1; o < 64; o <<= 1) { const double t = __shfl_up(pre, o); if (F.lane >= o) pre += t; }
            double run = pre - s; GAS v4u* xk = (GAS v4u*)(ws + WS_XK) + (size_t)gw * SEQ + 64 * F.lane; GAS v4u* xq = (GAS v4u*)(ws + WS_XQ) + (size_t)gw * SEQ + 64 * F.lane;
            for (int i = 0; i < 64; ++i) { run += (double)lp[i];
                const float q = (float)(run * 1.4426950408889634), c = -q;
                const unsigned c1 = f2bf(c); const float r1 = c - __uint_as_float(c1 << 16); const unsigned c2 = f2bf(r1); const float r2 = r1 - __uint_as_float(c2 << 16); const unsigned c3 = f2bf(r2);
                const unsigned q1 = f2bf(q); const float s1 = q - __uint_as_float(q1 << 16); const unsigned q2 = f2bf(s1); const float s2 = s1 - __uint_as_float(q2 << 16); const unsigned q3 = f2bf(s2);
                v4u a; a.x = c1 | (c2 << 16); a.y = c3 | 0x3F800000u; a.z = 0x3F803F80u; a.w = 0x3F803F80u; xk[i] = a;
                v4u bq; bq.x = 0x3F803F80u; bq.y = 0x3F80u | (q1 << 16); bq.z = q2 | (q3 << 16); bq.w = 0u; xq[i] = bq; }
        }
        pg8::EpiBf16<0> E{A1, D, nullptr, D, (size_t)(WS_A2 - WS_A1) / 2, C2};
        run_gemm(F, A0, D, 0, (const bf16*)(ws + WS_WQKV), 3 * D, D, E);
    }
    SEAM(PH_QKV);

    if (IN(PH_KMEAN)) REPEAT(PH_KMEAN) {
        for (int it = gw; it < BATCH * NMOBA * MOBA_NB; it += NGW) { const int n = it & 15, hm = (it >> 4) & 7, b = it >> 7;
            const bf16* kp = A2 + ((size_t)b * SEQ + n * MOBA_BLK) * D + (NFOX + hm) * HD + F.lane; float s = 0.f;
#pragma unroll 8
            for (int i = 0; i < MOBA_BLK; ++i) s += bf2f(kp[(size_t)i * D]);
            kmean[(size_t)it * HD + F.lane] = s * (1.f / MOBA_BLK); }
    }
    SEAM(PH_KMEAN);

    if (IN(PH_ATTN)) REPEAT(PH_ATTN) {
        attn_body::attn_phase<8>((char*)lds + RING_OFF, F.vcu, (const attn_body::bf16*)A1, (const attn_body::bf16*)A2, (const attn_body::bf16*)A3, (attn_body::bf16*)A4,
                                 (const attn_body::bf16*)(ws + WS_XK), (const attn_body::bf16*)(ws + WS_XQ), kmean);
    }
    SEAM(PH_ATTN);

    if (IN(PH_WOUT)) REPEAT(PH_WOUT) { pg8::EpiResid E{in[I_X], xres, mod + 2 * D, MOD6}; run_gemm(F, A4, D, 0, (const bf16*)(ws + WS_WOUT), D, D, E); }
    SEAM(PH_WOUT);

#define FFN_PHASES(l, PHN, PHI, PHO, WIN, WOUT_) \
    if (IN(PHN)) REPEAT(PHN) { for (int m = gw; m < M; m += NGW) { f32x4 h[4]; const float* mb = mod + ((size_t)(l) * BATCH + m / SEQ) * MOD6; \
            norm_row(xres + (size_t)m * D, A0 + (size_t)m * D, in[I_NFFN] + (l) * D, mb + 3 * D, mb + 4 * D, F.lane, h); } } \
    SEAM(PHN); \
    if (IN(PHI)) REPEAT(PHI) { pg8::EpiSwiglu E{A1, DFF}; run_gemm(F, A0, D, 0, (const bf16*)(ws + WIN), 2 * DFF, D, E); } \
    SEAM(PHI); \
    if (IN(PHO)) { pg8::EpiResid E{xres, xres, mod + (size_t)(l) * BATCH * MOD6 + 5 * D, MOD6}; run_gemm(F, A1, DFF, 0, (const bf16*)(ws + WOUT_), D, DFF, E); } \
    SEAM(PHO);
    FFN_PHASES(0, PH_NORMF0, PH_FFIN0, PH_FFOUT0, WS_WF0IN, WS_WF0OUT)

    if (IN(PH_NORM1)) REPEAT(PH_NORM1) {
        if (blockIdx.x == 0) { const v4u z = {0u, 0u, 0u, 0u}; if (F.tid < 4 * 128) { const int b = F.tid >> 7, c = F.tid & 127; ((GAS v4u*)(XN1G + (size_t)b * (SEQ + 1) * D))[c] = z; } }
        for (int m = gw; m < M; m += NGW) { f32x4 h[4]; const int b = m / SEQ; const float* mb = mod + ((size_t)BATCH + b) * MOD6;
            norm_row(xres + (size_t)m * D, XN1G + ((size_t)b * (SEQ + 1) + 1 + (m % SEQ)) * D, in[I_NMIX] + D, mb, mb + D, F.lane, h); }
    }
    SEAM(PH_NORM1);

    if (IN(PH_MIX)) REPEAT(PH_MIX) {
        const float* mu = in[I_MU];
        for (int m = gw; m < M; m += NGW) { const int b = m / SEQ; const bf16* hp = XN1G + ((size_t)b * (SEQ + 1) + (m % SEQ)) * D; const bf16* hc = hp + D;
#pragma unroll
            for (int j = 0; j < 4; ++j) { const int col = 4 * F.lane + 256 * j;
                const unsigned long long wc = *(const GAS unsigned long long*)(hc + col), wp = *(const GAS unsigned long long*)(hp + col);
                float c4[4] = {bflo((unsigned)wc), bfhi((unsigned)wc), bflo((unsigned)(wc >> 32)), bfhi((unsigned)(wc >> 32))};
                float p4[4] = {bflo((unsigned)wp), bfhi((unsigned)wp), bflo((unsigned)(wp >> 32)), bfhi((unsigned)(wp >> 32))};
                const f32x4 mr = *(const f32x4*)(mu + col), mk = *(const f32x4*)(mu + 2 * D + col), mv = *(const f32x4*)(mu + 3 * D + col);
                float xr[4], xk[4], xv[4];
#pragma unroll
                for (int e = 0; e < 4; ++e) { const float dx = p4[e] - c4[e]; xr[e] = c4[e] + dx * mr[e]; xk[e] = c4[e] + dx * mk[e]; xv[e] = c4[e] + dx * mv[e]; }
                const size_t o = (size_t)m * D + col;
                *(GAS unsigned long long*)(A1 + o) = (unsigned long long)pk2(xr[0], xr[1]) | ((unsigned long long)pk2(xr[2], xr[3]) << 32);
                *(GAS unsigned long long*)(A2 + o) = (unsigned long long)pk2(xk[0], xk[1]) | ((unsigned long long)pk2(xk[2], xk[3]) << 32);
                *(GAS unsigned long long*)(A3 + o) = (unsigned long long)pk2(xv[0], xv[1]) | ((unsigned long long)pk2(xv[2], xv[3]) << 32); } }
        __syncthreads();
        pg8::EpiBf16<1> E{A4, 512, nullptr, 0, 0, 1.f};
        run_gemm(F, XN1G, D, 1, (const bf16*)(ws + WS_WLD), 512, 2 * D, E);
    }
    SEAM(PH_MIX);

    if (IN(PH_RKV)) REPEAT(PH_RKV) {
        { pg8::EpiBf16<0> E{A5, D, nullptr, 0, 0, 1.f}; run_gemm(F, A1, D, 0, (const bf16*)(ws + WS_WR), D, D, E); }
        { pg8::EpiBf16<0> E{A0, D, nullptr, 0, 0, 1.f}; run_gemm(F, A2, D, 0, (const bf16*)(ws + WS_WK), D, D, E); }
        { pg8::EpiBf16<0> E{AM1, D, nullptr, 0, 0, 1.f}; run_gemm(F, A3, D, 0, (const bf16*)(ws + WS_WV), D, D, E); }
    }
    SEAM(PH_RKV);

    if (IN(PH_LORAUP)) REPEAT(PH_LORAUP) {
        { pg8::EpiBf16<0> E{A1, D, nullptr, 0, 0, 1.f}; run_gemm(F, A4, 512, 0, (const bf16*)(ws + WS_WW2), D, 128, E); }
        { pg8::EpiBf16<0> E{A2, D, nullptr, 0, 0, 1.f}; run_gemm(F, A4 + 128, 512, 0, (const bf16*)(ws + WS_WA2), D, 128, E); }
        { pg8::EpiBf16<0> E{A3, D, nullptr, 0, 0, 1.f}; run_gemm(F, A4 + 256, 512, 0, (const bf16*)(ws + WS_WG2), D, 256, E); }
    }
    SEAM(PH_LORAUP);

    if (IN(PH_R1)) {
        for (int item = F.vcu; item < (M / 64) * NH; item += F.G)
            rw::r1_item(F.lds + RING_OFF, item, A5, A0, AM1, A1, A2, in[I_W0], in[I_A0], in[I_KK], in[I_KA], in[I_RK], (float*)(ws + WS_BONUS));
    }
    SEAM(PH_R1);

    if (IN(PH_R2)) {
        if (F.wave == 0 && F.vcu < BATCH * NH * 2) rw::r2_item(F.vcu, A5, A1, A4, F.lane);
    }
    SEAM(PH_R2);

    if (IN(PH_R3)) {
        for (int item = gw; item < (M / 64) * NH; item += NGW)
            rw::r3_item(item, A4, A0, A2, AM1, A3, (const float*)(ws + WS_BONUS), in[I_LNW], in[I_LNB], F.lane);
    }
    SEAM(PH_R3);

    if (IN(PH_WO)) { pg8::EpiResid E{xres, xres, mod + (size_t)BATCH * MOD6 + 2 * D, MOD6}; run_gemm(F, A4, D, 0, (const bf16*)(ws + WS_WO), D, D, E); }
    SEAM(PH_WO);

    FFN_PHASES(1, PH_NORMF1, PH_FFIN1, PH_FFOUT1, WS_WF1IN, WS_WF1OUT)

    if (IN(PH_FINAL)) {
        for (int m = gw; m < M; m += NGW) { GAS f32x4* xr = (GAS f32x4*)(xres + (size_t)m * D) + F.lane; f32x4 v[4]; float s = 0.f;
#pragma unroll
            for (int j = 0; j < 4; ++j) { v[j] = xr[64 * j]; s += (v[j].x * v[j].x + v[j].y * v[j].y) + (v[j].z * v[j].z + v[j].w * v[j].w); }
            const float inv = 1.f / sqrtf(wave_sum(s) * (1.f / D) + NORM_EPS);
#pragma unroll
            for (int j = 0; j < 4; ++j) { const f32x4 gg = *(const f32x4*)(in[I_NFIN] + 4 * F.lane + 256 * j); xr[64 * j] = v[j] * inv * gg; } }
    }
#undef IN
#undef SEAM
}

extern "C" void kernel_launch(void* const* d_in, const int* in_sizes, int n_in, void* d_out, int out_size, void* d_ws, size_t ws_size, hipStream_t stream) {
    static int grid = 0;
    if (grid == 0) {
        if (n_in != N_IN || in_sizes[0] != M * D || out_size != M * D || ws_size < WS_END) { fprintf(stderr, "kernel_launch: unexpected shapes (n_in %d, in0 %d, out %d, ws %zu); nothing launched\n", n_in, n_in > 0 ? in_sizes[0] : -1, out_size, ws_size); grid = -1; return; }
        int dev = 0, cus = 0, per_cu = 0;
        if (hipGetDevice(&dev) != hipSuccess || hipDeviceGetAttribute(&cus, hipDeviceAttributeMultiprocessorCount, dev) != hipSuccess) { grid = -1; return; }
        if (hipFuncSetAttribute((const void*)mk_fwd, hipFuncAttributeMaxDynamicSharedMemorySize, LDS_BYTES) != hipSuccess) { fprintf(stderr, "kernel_launch: hipFuncSetAttribute failed\n"); grid = -1; return; }
        if (hipOccupancyMaxActiveBlocksPerMultiprocessor(&per_cu, (const void*)mk_fwd, NTHR, LDS_BYTES) != hipSuccess || per_cu < 1) fprintf(stderr, "kernel_launch: note: occupancy query reports %d\n", per_cu);
        (void)hipGetLastError();
        grid = cus;
    }
    if (grid < 0) return;
    if (hipMemsetAsync((char*)d_ws + WS_CTL, 0, CTL_ZERO_BYTES, stream) != hipSuccess) { fprintf(stderr, "kernel_launch: memset failed\n"); return; }
    Args a{};
    for (int i = 0; i < N_IN; ++i) a.in[i] = (const float*)d_in[i];
    a.out = (float*)d_out; a.ws = (unsigned char*)d_ws;
#if MK_ONE_LAUNCH
    a.ph_lo = 0; a.ph_hi = N_PHASES;
    hipLaunchKernelGGL(mk_fwd, dim3(grid), dim3(NTHR), LDS_BYTES, stream, a);
#else
    for (int p = 0; p < N_PHASES; ++p) { a.ph_lo = p; a.ph_hi = p + 1; hipLaunchKernelGGL(mk_fwd, dim3(grid), dim3(NTHR), LDS_BYTES, stream, a); }
#endif
    const hipError_t le = hipPeekAtLastError();
    if (le != hipSuccess) fprintf(stderr, "kernel_launch: launch failed: %s\n", hipGetErrorName(le));
}
```
